# Optimizing an MI355X kernel written in HIP

```python
import math
import jax, jax.numpy as jnp
from jax import lax
import numpy as np

D_MODEL = 1024
BATCH = 4
SEQ = 8192
DEPTH = 2

HEAD_DIM = 64
SWA_Q_HEADS = 8
SWA_KV_HEADS = 2
SWA_WINDOW = 128
FOX_HEADS = 8
Q_BLOCK = 128
N_BUCKETS = 32
MAX_DISTANCE = 128
N_EXPERTS = 256
TOP_K = 8
N_GROUPS = 8
TOPK_GROUPS = 4
D_EXPERT = 256
D_SHARED = 256
ROUTED_SCALE = 2.5
EXPERT_BLOCK = 256
LN_EPS = 1e-5
ALPHA = (2 * DEPTH) ** 0.25
BETA = (8 * DEPTH) ** -0.25

SWA_Q = SWA_Q_HEADS * HEAD_DIM
SWA_KV = SWA_KV_HEADS * HEAD_DIM
FOX_W = FOX_HEADS * HEAD_DIM
IN_SIZES = (SWA_Q, SWA_KV, SWA_KV, FOX_W, FOX_W, FOX_W, FOX_HEADS, D_MODEL, D_MODEL)
IN_COLS = SWA_Q + 2 * SWA_KV + 3 * FOX_W + FOX_HEADS + 2 * D_MODEL

kernel_name = "hybrid_swa_fox_moe_deepnorm"


def layer_norm(x, g, b):
    xf = x.astype(jnp.float32)
    mu = xf.mean(-1, keepdims=True)
    var = jnp.square(xf - mu).mean(-1, keepdims=True)
    y = (xf - mu) * lax.rsqrt(var + LN_EPS)
    return (y * g.astype(jnp.float32) + b.astype(jnp.float32)).astype(x.dtype)


def t5_bucket(dist):
    n = jnp.maximum(dist, 0)
    max_exact = N_BUCKETS // 2
    nf = jnp.maximum(n, 1).astype(jnp.float32)
    large = max_exact + (jnp.log(nf / max_exact) / math.log(MAX_DISTANCE / max_exact)
                         * (N_BUCKETS - max_exact)).astype(jnp.int32)
    large = jnp.minimum(large, N_BUCKETS - 1)
    return jnp.where(n < max_exact, n, large)


def swa_attention(q, k, v, sinks, rel_bias):
    B, S = q.shape[:2]
    nb = S // Q_BLOCK
    G = SWA_Q_HEADS // SWA_KV_HEADS
    qb = q.reshape(B, nb, Q_BLOCK, SWA_KV_HEADS, G, HEAD_DIM)

    def band(t):
        tb = t.reshape(B, nb, Q_BLOCK, SWA_KV_HEADS, HEAD_DIM)
        prev = jnp.pad(tb[:, :-1], ((0, 0), (1, 0), (0, 0), (0, 0), (0, 0)))
        return jnp.concatenate([prev, tb], axis=2)

    kb, vb = band(k), band(v)
    s = jnp.einsum('bnqkgd,bnskd->bnkgqs', qb, kb).astype(jnp.float32) * (HEAD_DIM ** -0.5)
    i = jnp.arange(Q_BLOCK)[:, None]
    j = jnp.arange(2 * Q_BLOCK)[None, :]
    dist = i + Q_BLOCK - j
    blk = jnp.arange(nb)[:, None, None]
    key_pos = (blk - 1) * Q_BLOCK + j[None]
    valid = (dist >= 0)[None] & (dist < SWA_WINDOW)[None] & (key_pos >= 0)
    bias = rel_bias[t5_bucket(dist)].astype(jnp.float32)
    bias = bias.transpose(2, 0, 1).reshape(SWA_KV_HEADS, G, Q_BLOCK, 2 * Q_BLOCK)
    s = jnp.where(valid[None, :, None, None], s + bias[None, None], -jnp.inf)
    sink = sinks.astype(jnp.float32).reshape(SWA_KV_HEADS, G)[None, None, :, :, None, None]
    m = jnp.maximum(s.max(-1, keepdims=True), sink)
    p = jnp.exp(s - m)
    denom = p.sum(-1, keepdims=True) + jnp.exp(sink - m)
    o = jnp.einsum('bnkgqs,bnskd->bnqkgd', (p / denom).astype(v.dtype), vb)
    return o.reshape(B, S, SWA_Q)


def forgetting_attention(q, k, v, log_f):
    B, S = q.shape[:2]
    nb = S // Q_BLOCK
    c = jnp.cumsum(log_f, axis=1)
    c_keys = c.transpose(0, 2, 1)
    q_blocks = q.reshape(B, nb, Q_BLOCK, FOX_HEADS, HEAD_DIM).transpose(1, 0, 2, 3, 4)
    c_blocks = c.reshape(B, nb, Q_BLOCK, FOX_HEADS).transpose(1, 0, 3, 2)
    key_pos = jnp.arange(S)
    scale = HEAD_DIM ** -0.5

    def one_block(args):
        qb, cb, n = args
        s = jnp.einsum('bqhd,bshd->bhqs', qb, k).astype(jnp.float32) * scale
        s = s + cb[..., None] - c_keys[:, :, None, :]
        q_pos = n * Q_BLOCK + jnp.arange(Q_BLOCK)
        s = jnp.where(key_pos[None, :] <= q_pos[:, None], s, -jnp.inf)
        p = jax.nn.softmax(s, axis=-1)
        return jnp.einsum('bhqs,bshd->bqhd', p.astype(v.dtype), v)

    o = lax.map(one_block, (q_blocks, c_blocks, jnp.arange(nb)))
    return o.transpose(1, 0, 2, 3, 4).reshape(B, S, FOX_W)


def moe(x2, w_router, router_bias, w_gate_e, w_up_e, w_down_e, w_gate_s, w_up_s, w_down_s):
    T, D = x2.shape
    scores = jax.nn.sigmoid((x2 @ w_router).astype(jnp.float32))
    biased = scores + router_bias.astype(jnp.float32)
    grouped = biased.reshape(T, N_GROUPS, N_EXPERTS // N_GROUPS)
    group_score = lax.top_k(grouped, 2)[0].sum(-1)
    _, top_groups = lax.top_k(group_score, TOPK_GROUPS)
    group_mask = (top_groups[..., None] == jnp.arange(N_GROUPS)).any(1)
    expert_mask = jnp.repeat(group_mask, N_EXPERTS // N_GROUPS, axis=1)
    _, top_e = lax.top_k(jnp.where(expert_mask, biased, -jnp.inf), TOP_K)
    w = jnp.take_along_axis(scores, top_e, axis=1)
    w = w / w.sum(-1, keepdims=True) * ROUTED_SCALE

    N = T * TOP_K
    flat_e = top_e.reshape(-1)
    flat_tok = jnp.arange(N, dtype=jnp.int32) // TOP_K
    flat_w = w.reshape(-1)
    order = jnp.argsort(flat_e)
    e_sorted = flat_e[order]
    counts = jnp.zeros((N_EXPERTS,), jnp.int32).at[flat_e].add(1)
    padded = (counts + EXPERT_BLOCK - 1) // EXPERT_BLOCK * EXPERT_BLOCK
    start = jnp.cumsum(counts) - counts
    pend = jnp.cumsum(padded)
    pstart = pend - padded
    dest = pstart[e_sorted] + jnp.arange(N, dtype=jnp.int32) - start[e_sorted]
    P = (N + N_EXPERTS * (EXPERT_BLOCK - 1) + EXPERT_BLOCK - 1) // EXPERT_BLOCK * EXPERT_BLOCK
    n_blocks = P // EXPERT_BLOCK
    row_tok = jnp.zeros((P,), jnp.int32).at[dest].set(flat_tok[order])
    row_w = jnp.zeros((P,), jnp.float32).at[dest].set(flat_w[order])
    block_e = jnp.minimum(
        jnp.searchsorted(pend, jnp.arange(n_blocks, dtype=jnp.int32) * EXPERT_BLOCK, side='right'),
        N_EXPERTS - 1)

    def step(acc, blk):
        tok, rw, e = blk
        xb = x2[tok]
        h = jax.nn.silu(xb @ w_gate_e[e]) * (xb @ w_up_e[e])
        yb = (h @ w_down_e[e]).astype(jnp.float32) * rw[:, None]
        return acc.at[tok].add(yb), None

    routed, _ = lax.scan(step, jnp.zeros((T, D), jnp.float32),
                         (row_tok.reshape(n_blocks, EXPERT_BLOCK),
                          row_w.reshape(n_blocks, EXPERT_BLOCK), block_e))
    shared = (jax.nn.silu(x2 @ w_gate_s) * (x2 @ w_up_s)) @ w_down_s
    return shared + routed.astype(x2.dtype)


def setup_inputs(seed: int = 0) -> dict:
    key = jax.random.key(seed)
    ks = jax.random.split(key, 24)
    f32 = jnp.float32
    nrm = lambda k, shape, s: jax.random.normal(k, shape, f32) * s
    col_scale = jnp.concatenate([
        jnp.full((n,), BETA if idx in (2, 5) else 1.0, f32) for idx, n in enumerate(IN_SIZES)])
    return {
        "x": nrm(ks[0], (BATCH, SEQ, D_MODEL), 1.0),
        "w_in": nrm(ks[1], (DEPTH, D_MODEL, IN_COLS), D_MODEL ** -0.5) * col_scale,
        "b_forget": jax.random.uniform(ks[2], (DEPTH, FOX_HEADS), f32, 1.0, 5.0),
        "attn_sinks": nrm(ks[3], (DEPTH, SWA_Q_HEADS), 0.5),
        "rel_bias": nrm(ks[4], (N_BUCKETS, SWA_Q_HEADS), 0.5),
        "w_proj_a": nrm(ks[5], (DEPTH, SWA_Q, D_MODEL), SWA_Q ** -0.5),
        "w_proj_b": nrm(ks[6], (DEPTH, FOX_W, D_MODEL), FOX_W ** -0.5),
        "w_out": nrm(ks[7], (DEPTH, D_MODEL, D_MODEL), D_MODEL ** -0.5 * BETA),
        "ln1_g": 1.0 + nrm(ks[8], (DEPTH, D_MODEL), 0.02),
        "ln1_b": nrm(ks[9], (DEPTH, D_MODEL), 0.02),
        "w_router": nrm(ks[10], (DEPTH, D_MODEL, N_EXPERTS), D_MODEL ** -0.5),
        "router_bias": nrm(ks[11], (DEPTH, N_EXPERTS), 0.01),
        "w_gate_e": nrm(ks[12], (DEPTH, N_EXPERTS, D_MODEL, D_EXPERT), D_MODEL ** -0.5),
        "w_up_e": nrm(ks[13], (DEPTH, N_EXPERTS, D_MODEL, D_EXPERT), D_MODEL ** -0.5),
        "w_down_e": nrm(ks[14], (DEPTH, N_EXPERTS, D_EXPERT, D_MODEL), D_EXPERT ** -0.5 * BETA),
        "w_gate_s": nrm(ks[15], (DEPTH, D_MODEL, D_SHARED), D_MODEL ** -0.5),
        "w_up_s": nrm(ks[16], (DEPTH, D_MODEL, D_SHARED), D_MODEL ** -0.5),
        "w_down_s": nrm(ks[17], (DEPTH, D_SHARED, D_MODEL), D_SHARED ** -0.5 * BETA),
        "ln2_g": 1.0 + nrm(ks[18], (DEPTH, D_MODEL), 0.02),
        "ln2_b": nrm(ks[19], (DEPTH, D_MODEL), 0.02),
    }


def reference(x, w_in, b_forget, attn_sinks, rel_bias, w_proj_a, w_proj_b, w_out, ln1_g, ln1_b,
              w_router, router_bias, w_gate_e, w_up_e, w_down_e, w_gate_s, w_up_s, w_down_s,
              ln2_g, ln2_b):
    B, S, D = x.shape
    split_at = np.cumsum(np.array(IN_SIZES))[:-1].tolist()
    for l in range(DEPTH):
        proj = x @ w_in[l]
        qa, ka, va, qf, kf, vf, zf, ga, gb = jnp.split(proj, split_at, axis=-1)
        ya = swa_attention(qa.reshape(B, S, SWA_Q_HEADS, HEAD_DIM),
                           ka.reshape(B, S, SWA_KV_HEADS, HEAD_DIM),
                           va.reshape(B, S, SWA_KV_HEADS, HEAD_DIM),
                           attn_sinks[l], rel_bias)
        log_f = jax.nn.log_sigmoid((zf + b_forget[l]).astype(jnp.float32))
        yb = forgetting_attention(qf.reshape(B, S, FOX_HEADS, HEAD_DIM),
                                  kf.reshape(B, S, FOX_HEADS, HEAD_DIM),
                                  vf.reshape(B, S, FOX_HEADS, HEAD_DIM), log_f)
        mix = jax.nn.sigmoid(ga) * (ya @ w_proj_a[l]) + jax.nn.sigmoid(gb) * (yb @ w_proj_b[l])
        x = layer_norm(ALPHA * x + mix @ w_out[l], ln1_g[l], ln1_b[l])
        y = moe(x.reshape(B * S, D), w_router[l], router_bias[l], w_gate_e[l], w_up_e[l],
                w_down_e[l], w_gate_s[l], w_up_s[l], w_down_s[l]).reshape(B, S, D)
        x = layer_norm(ALPHA * x + y, ln2_g[l], ln2_b[l])
    return x
```

```cpp
#include <hip/hip_runtime.h>
#include <cstdio>
#include <cstdint>

constexpr int BATCH = 4, SEQ = 8192, D = 1024, T = BATCH * SEQ, DEPTH = 2;
constexpr int HD = 64, AQH = 8, AKVH = 2, WIN = 128, FH = 8;
constexpr int NE = 256, TOPK = 8, NG = 8, TOPG = 4, DE = 256, DS = 256, EB = 256;
constexpr int IN_COLS = 4360, PC = 4352;
constexpr int OC_AQ = 0, OC_AK = 512, OC_AV = 640, OC_BQ = 768, OC_BK = 1280, OC_BV = 1792, OC_ZF = 2304, OC_GA = 2312, OC_GB = 3336;
constexpr int PC_AQ = 0, PC_AK = 512, PC_AV = 640, PC_BQ = 768, PC_BK = 1280, PC_BV = 1792, PC_GA = 2304, PC_GB = 3328;
constexpr int NASSIGN = T * TOPK;
constexpr int PROWS = (NASSIGN + NE * (EB - 1) + EB - 1) / EB * EB;
constexpr int NRB = PROWS / EB;
constexpr float LN_EPS = 1e-5f;
constexpr float ALPHA = 1.41421356237309515f;
constexpr float ROUTED_SCALE = 2.5f;
constexpr float LOG2E = 1.4426950408889634f;
constexpr float C2 = 0.125f * 1.4426950408889634f;
constexpr int CHUNK = 128, NCHUNK = T / CHUNK;

constexpr size_t MiB = 1u << 20;
constexpr size_t WS_CTL = 0, CTL_ZERO_BYTES = 1 * MiB;
constexpr size_t WS_WSMALL = 2 * MiB;
constexpr size_t WS_LOGF = 40 * MiB, WS_C = 41 * MiB, WS_TOPE = 42 * MiB, WS_TOPW = 43 * MiB, WS_INV = 44 * MiB;
constexpr size_t WS_ROWTOK = 45 * MiB, WS_ROWW = 47 * MiB, WS_CNT = 49 * MiB, WS_BLKE = 50 * MiB, WS_CKB = 51 * MiB, WS_KN2 = 52 * MiB;
constexpr size_t WS_XH = 64 * MiB, WS_X1H = 128 * MiB, WS_LOGITS = 192 * MiB, WS_HS = 224 * MiB;
constexpr size_t WS_XA = 256 * MiB, WS_PRE = 384 * MiB, WS_X1 = 512 * MiB, WS_H = 640 * MiB;
constexpr size_t WS_R1 = 800 * MiB;
constexpr size_t WS_PROJ = WS_R1, WS_YA = WS_R1 + 272 * MiB, WS_YB = WS_R1 + 304 * MiB, WS_MIX = WS_R1 + 336 * MiB, WS_Y = WS_R1;
constexpr size_t WS_WEXP = 1440 * MiB, WS_END = 1824 * MiB;
static_assert((size_t)T * PC * 2 <= 272 * MiB && (size_t)PROWS * D * 1 <= 640 * MiB && (size_t)PROWS * DE * 2 <= 160 * MiB, "ws map");
constexpr int CW_BAR = 4096;
constexpr int CW_NB = 64;
constexpr int CW_AQ = 128, CW_CQ = 256;

constexpr int RING_OFF = 0, RING_BYTES = 131072;
constexpr int LDSCTL_OFF = RING_BYTES, MISC_OFF = LDSCTL_OFF + 320;
constexpr int LDS_BYTES = 147456;
constexpr int NWAVES = 8, NTHR = 512;

#define GAS __attribute__((address_space(1)))
typedef unsigned short bf16;
typedef float f32x4 __attribute__((ext_vector_type(4)));
typedef float f32x2 __attribute__((ext_vector_type(2)));
typedef unsigned u32x4 __attribute__((ext_vector_type(4)));
typedef unsigned u32x2 __attribute__((ext_vector_type(2)));
typedef short bf16x8 __attribute__((ext_vector_type(8)));

__device__ __forceinline__ float bf2f(unsigned v) { return __uint_as_float(v << 16); }
__device__ __forceinline__ unsigned f2bf(float f) { unsigned u = __float_as_uint(f); return (u + 0x7fffu + ((u >> 16) & 1u)) >> 16; }
__device__ __forceinline__ unsigned pk2(float lo, float hi) { unsigned r; asm("v_cvt_pk_bf16_f32 %0, %1, %2" : "=v"(r) : "v"(lo), "v"(hi)); return r; }
__device__ __forceinline__ float sat8(float v) { return __builtin_amdgcn_fmed3f(v, -448.0f, 448.0f); }
__device__ __forceinline__ int cvt2_fp8(float a, float b, int old, bool hi) { return hi ? __builtin_amdgcn_cvt_pk_fp8_f32(sat8(a), sat8(b), old, true) : __builtin_amdgcn_cvt_pk_fp8_f32(sat8(a), sat8(b), old, false); }
__device__ __forceinline__ float sigmoidf_(float v) { return __builtin_amdgcn_rcpf(1.0f + __expf(-v)); }
__device__ __forceinline__ float siluf_(float v) { return v * __builtin_amdgcn_rcpf(1.0f + __expf(-v)); }
__device__ __forceinline__ int lane_id_opaque() { int l; asm volatile("v_mbcnt_lo_u32_b32 %0, -1, 0\n\tv_mbcnt_hi_u32_b32 %0, -1, %0" : "=v"(l)); return l; }
__device__ __forceinline__ float rdlane_f(float v, int l) { return __int_as_float(__builtin_amdgcn_readlane(__float_as_int(v), l)); }
template <int CTRL> __device__ __forceinline__ float dpp_f(float v) { return __int_as_float(__builtin_amdgcn_update_dpp(0, __float_as_int(v), CTRL, 0xf, 0xf, true)); }
__device__ __forceinline__ float wave_max_all(float v) {
    v = fmaxf(v, dpp_f<0xB1>(v)); v = fmaxf(v, dpp_f<0x4E>(v)); v = fmaxf(v, dpp_f<0x141>(v)); v = fmaxf(v, dpp_f<0x140>(v));
    const float r0 = rdlane_f(v, 0), r1 = rdlane_f(v, 16), r2 = rdlane_f(v, 32), r3 = rdlane_f(v, 48);
    return fmaxf(fmaxf(r0, r1), fmaxf(r2, r3));
}
__device__ __forceinline__ float wave_sum(float v) {
    v += dpp_f<0xB1>(v); v += dpp_f<0x4E>(v); v += dpp_f<0x141>(v); v += dpp_f<0x140>(v);
    return (rdlane_f(v, 0) + rdlane_f(v, 16)) + (rdlane_f(v, 32) + rdlane_f(v, 48));
}
__device__ const unsigned char T5_BUCKET[128] = {0, 1, 2, 3, 4, 5, 6, 7, 8, 9, 10, 11, 12, 13, 14, 15, 16, 16, 16, 17, 17, 18, 18, 18, 19, 19, 19, 20, 20, 20, 20, 21, 21, 21, 21, 22, 22, 22, 22, 22, 23, 23, 23, 23, 23, 23, 24, 24, 24, 24, 24, 24, 25, 25, 25, 25, 25, 25, 25, 26, 26, 26, 26, 26, 26, 26, 26, 27, 27, 27, 27, 27, 27, 27, 27, 27, 27, 28, 28, 28, 28, 28, 28, 28, 28, 28, 28, 29, 29, 29, 29, 29, 29, 29, 29, 29, 29, 29, 29, 30, 30, 30, 30, 30, 30, 30, 30, 30, 30, 30, 30, 30, 30, 31, 31, 31, 31, 31, 31, 31, 31, 31, 31, 31, 31, 31, 31, 31};

constexpr size_t WSMALL_LAYER = 15 * MiB, WSM_WIN = 0, WSM_WPA = 8 * MiB + 512 * 1024, WSM_WPB = WSM_WPA + MiB, WSM_WOUT = WSM_WPB + MiB, WSM_WRS = WSM_WOUT + 2 * MiB, WSM_WDS = WSM_WRS + MiB + 512 * 1024;
static_assert((size_t)PC * D * 2 <= WSM_WPA && WSM_WDS + 512 * 1024 <= WSMALL_LAYER && WS_WSMALL + 2 * WSMALL_LAYER <= WS_LOGF, "small weights map");
constexpr int BLKE_LDS_OFF = RING_BYTES + 1024;
static_assert(BLKE_LDS_OFF + NRB * 4 <= LDS_BYTES, "LDS map");

constexpr int NATT = 160;
#define XB_TMO      128
#define XB_XCNT(j)  (256  + 64 * (j))
#define XB_XSUB(j)  (1280 + 64 * (j))
#define XB_XGEN(j)  (2304 + 64 * (j))
#define XB_TOP      3328
#define XB_TOPGEN   3392
#define XCD_BAR_WORDS 3456
#define XB_SPIN_CAP (1u << 18)
#define LAS __attribute__((address_space(3)))

__device__ __forceinline__ unsigned xb_ld(unsigned* p)              { return __hip_atomic_load(p, __ATOMIC_RELAXED, __HIP_MEMORY_SCOPE_AGENT); }
__device__ __forceinline__ unsigned xb_add(unsigned* p, unsigned v) { return __hip_atomic_fetch_add(p, v, __ATOMIC_RELAXED, __HIP_MEMORY_SCOPE_AGENT); }
__device__ __forceinline__ unsigned xb_xcc_id() { return (unsigned)__builtin_amdgcn_s_getreg((3 << 11) | 20) & 0xFu; }
#define XB_SPIN(cond, bar) do { unsigned _sp = 0; while (cond) { __builtin_amdgcn_s_sleep(1); \
    if ((++_sp & 255u) == 0u) { if (xb_ld(&(bar)[XB_TMO])) break; if (_sp > XB_SPIN_CAP) { atomicAdd(&(bar)[XB_TMO], 1u); break; } } } } while (0)

struct XcdBarrier {
    unsigned* bar; unsigned x;
    volatile LAS unsigned* st;
    unsigned wv;
};
#define XB_THREAD0(b) ((b).wv == 0u && lane_id_opaque() == 0)

__device__ __forceinline__ XcdBarrier xcd_barrier_post(unsigned* bar, volatile LAS unsigned* st, unsigned wv) {
    XcdBarrier b; b.bar = bar; b.x = xb_xcc_id(); b.st = st; b.wv = wv;
    if (XB_THREAD0(b)) (void)xb_add(&bar[XB_XCNT(b.x)], 1u);
    return b;
}
__device__ __forceinline__ void xcd_barrier_complete(unsigned* bar, unsigned x, unsigned& nloc, unsigned& nx) {
    const unsigned G = gridDim.x * gridDim.y * gridDim.z;
    unsigned sum, cnt, mine, sp = 0u;
    for (;;) {
        sum = 0u; cnt = 0u; mine = 0u;
#pragma unroll
        for (unsigned j = 0; j < 16; ++j) { const unsigned c = xb_ld(&bar[XB_XCNT(j)]); sum += c; cnt += (c > 0u) ? 1u : 0u; mine = (j == x) ? c : mine; }
        if (sum == G) break;
        __builtin_amdgcn_s_sleep(1);
        if ((++sp & 255u) == 0u) { if (xb_ld(&bar[XB_TMO])) break; if (sp > XB_SPIN_CAP) { atomicAdd(&bar[XB_TMO], 1u); break; } }
    }
    nloc = mine > 0u ? mine : 1u; nx = cnt > 0u ? cnt : 1u;
}

__device__ __forceinline__ void xcd_barrier(const XcdBarrier& b) {
    asm volatile("s_waitcnt vmcnt(0)" ::: "memory");
    __syncthreads();
    if (XB_THREAD0(b)) {
        unsigned* bar = b.bar;
        __builtin_amdgcn_s_waitcnt(0);
        unsigned nloc = b.st[0], nx = b.st[1];
        if (nloc == 0u) { xcd_barrier_complete(bar, b.x, nloc, nx); b.st[0] = nloc; b.st[1] = nx; }
        const unsigned old = xb_add(&bar[XB_XSUB(b.x)], 1u);
        const unsigned gen = old / nloc;
        if (old + 1u == (gen + 1u) * nloc) {
            __builtin_amdgcn_fence(__ATOMIC_RELEASE, "agent");
            asm volatile("s_waitcnt vmcnt(0)" ::: "memory");
            const unsigned og = xb_add(&bar[XB_TOP], 1u);
            const unsigned tg = og / nx;
            if (og + 1u == (tg + 1u) * nx) xb_add(&bar[XB_TOPGEN], 1u);
            else XB_SPIN(xb_ld(&bar[XB_TOPGEN]) == tg, bar);
            __builtin_amdgcn_fence(__ATOMIC_ACQUIRE, "agent");
            xb_add(&bar[XB_XGEN(b.x)], 1u);
            asm volatile("s_waitcnt vmcnt(0)" ::: "memory");
        } else {
            XB_SPIN(xb_ld(&bar[XB_XGEN(b.x)]) == gen, bar);
            __builtin_amdgcn_fence(__ATOMIC_ACQUIRE, "agent");
            asm volatile("s_waitcnt vmcnt(0)" ::: "memory");
        }
    }
    __syncthreads();
}


namespace pg8 {
typedef unsigned short bf16_t;
constexpr int BM = 256, BK = 64, HALF = 128, HTB = HALF * BK * 2  , STAGE_BYTES = 8 * HTB, NXCD = 8, WGM = 8;

__host__ __device__ __forceinline__ int lds_byte(int r, int c) { const int st = (r >> 4) * 2 + (c >> 5), rr = r & 15, cc = c & 31, ob = rr * 64 + cc * 2; return st * 1024 + (ob ^ (((ob >> 9) & 1) << 5)); }
__host__ __device__ __forceinline__ void stage_rc(int b, int& R, int& C) { const int st = b / 1024, sb = b % 1024, swz = sb ^ (((sb >> 9) & 1) << 5); R = (st >> 1) * 16 + swz / 64; C = (st & 1) * 32 + (swz % 64) / 2; }
__host__ __device__ __forceinline__ int perm32(int rho) { const int n = rho >> 4, i = rho & 15; return 8 * (i >> 2) + 4 * n + (i & 3); }

struct Unit { int pm, pn, e; };

__device__ __forceinline__ bool xcd_linear(int i, int G, int c, int nwg, int& wgid) {
    const long L = (long)i * G + c; if (L >= nwg) return false;
    wgid = (int)L; { const int q = nwg / NXCD, r = nwg % NXCD, xcd = wgid % NXCD, off = wgid / NXCD; wgid = (xcd < r ? xcd * (q + 1) : r * (q + 1) + (xcd - r) * q) + off; }
    return true;
}
template <bool FP8_> struct DenseT {
    static constexpr bool GATHER = false, FP8 = FP8_; int sa, sb;
    const bf16_t* A; const bf16_t* Bt; int K, lda, ldb; const int* rowidx;
    int nM, nN, nwg, G, c;
    __device__ __forceinline__ void init(const bf16_t* A_, int lda_, const bf16_t* Bt_, int ldb_, int M, int N, int K_, int G_, int c_) { A = A_; Bt = Bt_; K = K_; lda = lda_; ldb = ldb_; rowidx = nullptr; nM = M / BM; nN = N / BM; nwg = nM * nN; G = G_; c = c_; }
    __device__ __forceinline__ bool next(int i, Unit& u) const {
        int wgid; if (!xcd_linear(i, G, c, nwg, wgid)) return false;
        const int nig = WGM * nN, gid = wgid / nig, fm = gid * WGM, gsz = (nM - fm) < WGM ? (nM - fm) : WGM;
        u.pm = fm + ((wgid % nig) % gsz); u.pn = (wgid % nig) / gsz; u.e = 0; return true;
    }
    __device__ __forceinline__ const char* a_base(const Unit& u) const { return (const char*)A + (size_t)u.pm * BM * lda * 2; }
    __device__ __forceinline__ const char* b_base(const Unit& u) const { return (const char*)Bt + (size_t)u.pn * BM * ldb * 2; }
};
typedef DenseT<false> Dense;
template <bool GATHER_, int NPN, bool FP8_ = false>
struct Grouped {
    static constexpr bool GATHER = GATHER_, FP8 = FP8_; int sa, sb;
    const bf16_t* A; const bf16_t* Bt; int K, lda, ldb; const int* rowidx; const LAS int* blke; size_t bstride;
    int nwg, G, c;
    __device__ __forceinline__ bool next(int i, Unit& u) const {
        if constexpr (NPN == 4) {
            int w2; if (!xcd_linear(i >> 1, G, c, nwg >> 1, w2)) return false;
            u.pm = w2 >> 1; u.pn = ((w2 & 1) << 1) | (i & 1); u.e = blke[u.pm]; return true;
        } else {
            int wgid; if (!xcd_linear(i, G, c, nwg, wgid)) return false;
            u.pm = wgid / NPN; u.pn = wgid % NPN; u.e = blke[u.pm]; return true;
        }
    }
    __device__ __forceinline__ const char* a_base(const Unit& u) const { return GATHER_ ? (const char*)A : (const char*)A + (size_t)u.pm * BM * lda * 2; }
    __device__ __forceinline__ const char* b_base(const Unit& u) const { return (const char*)(Bt + (size_t)u.e * bstride) + (size_t)u.pn * BM * ldb * 2; }
};

__device__ __forceinline__ unsigned cvt_pk_bf16(float lo, float hi) { unsigned r; asm volatile("v_cvt_pk_bf16_f32 %0, %1, %2" : "=v"(r) : "v"(lo), "v"(hi)); return r; }

template <class Epi, class Prob, bool ALIGN_EPI, bool SP2>
__device__ __forceinline__ void gemm_phase(LAS unsigned char* lds, const Prob& P, const Epi& E, int tid_in) {
    constexpr bool GA = Prob::GATHER, F8 = Prob::FP8;
    typedef int v8i32 __attribute__((ext_vector_type(8))); typedef int v4i32 __attribute__((ext_vector_type(4)));
    int sc_a = 0, sc_b = 0; if constexpr (F8) { sc_a = P.sa; sc_b = P.sb; }
    int tid_ = tid_in; asm volatile("" : "+v"(tid_));
    const int tid = tid_, wid = __builtin_amdgcn_readfirstlane(tid >> 6), lane = tid & 63, wr = wid >> 2, wc = wid & 3, fr = lane & 15, fq = lane >> 4;
    int K_ = P.K; asm volatile("" : "+s"(K_));
    const int K = K_, nt = K / BK;
    unsigned voffB[2], vAc[2][2], vAn[2][2]; int RA[2]; unsigned CA2[2];
    const unsigned ldab = (unsigned)P.lda * 2u;
#pragma unroll
    for (int i = 0; i < 2; ++i) { int R, C; stage_rc(tid * 16 + i * 8192, R, C); const int Rb = Epi::PERM ? ((R & ~31) + perm32(R & 31)) : R;
        voffB[i] = (unsigned)(Rb * P.ldb + C) * 2u; RA[i] = R; CA2[i] = (unsigned)C * 2u;
        vAc[0][i] = (unsigned)R * ldab + CA2[i]; vAc[1][i] = vAc[0][i] + (unsigned)HALF * ldab; vAn[0][i] = vAc[0][i]; vAn[1][i] = vAc[1][i]; }
    const size_t kstep = (size_t)(BK * 2);
    const size_t hstepB = (size_t)HALF * P.ldb * 2;
    const unsigned ldsw = (unsigned)wid * 1024u;
    const int aoff = lds_byte(wr * 64 + fr, fq * 8), boff = lds_byte(wc * 32 + fr, fq * 8);
#define PG8_SA(b, h) (((b) * 2 + (h)) * HTB)
#define PG8_SB(b, h) ((4 + (b) * 2 + (h)) * HTB)
#define PG8_STAGE(bufoff, gbase, voff) do { _Pragma("unroll") for (int _i = 0; _i < 2; ++_i) \
        __builtin_amdgcn_global_load_lds((const unsigned*)((const char*)(gbase) + (voff)[_i]), (LAS unsigned*)(lds + (bufoff) + ldsw + _i * 8192), 16, 0, 0); } while (0)
#define PG8_LDA(dst, b, h) do { if constexpr (F8) { _Pragma("unroll") for (int m = 0; m < 4; ++m) dst##8[m] = __builtin_shufflevector(*(const LAS v4i32*)(lds + PG8_SA(b, h) + aoff + m * 2048), *(const LAS v4i32*)(lds + PG8_SA(b, h) + aoff + m * 2048 + 1024), 0, 1, 2, 3, 4, 5, 6, 7); } \
    else { _Pragma("unroll") for (int m = 0; m < 4; ++m) _Pragma("unroll") for (int k = 0; k < 2; ++k) dst[m][k] = *(const LAS bf16x8*)(lds + PG8_SA(b, h) + aoff + m * 2048 + k * 1024); } } while (0)
#define PG8_LDB(dst, b, h) do { if constexpr (F8) { _Pragma("unroll") for (int n = 0; n < 2; ++n) dst##8[n] = __builtin_shufflevector(*(const LAS v4i32*)(lds + PG8_SB(b, h) + boff + n * 2048), *(const LAS v4i32*)(lds + PG8_SB(b, h) + boff + n * 2048 + 1024), 0, 1, 2, 3, 4, 5, 6, 7); } \
    else { _Pragma("unroll") for (int n = 0; n < 2; ++n) _Pragma("unroll") for (int k = 0; k < 2; ++k) dst[n][k] = *(const LAS bf16x8*)(lds + PG8_SB(b, h) + boff + n * 2048 + k * 1024); } } while (0)
#define PG8_MMA16(ai, bj, At, Bt) do { __builtin_amdgcn_s_setprio(1); _Pragma("unroll") for (int m = 0; m < 4; ++m) _Pragma("unroll") for (int n = 0; n < 2; ++n) _Pragma("unroll") for (int k = 0; k < 2; ++k) \
        acc[ai][bj][m][n] = __builtin_amdgcn_mfma_f32_16x16x32_bf16(Bt[n][k], At[m][k], acc[ai][bj][m][n], 0, 0, 0); __builtin_amdgcn_s_setprio(0); } while (0)
#define PG8_MMA(ai, bj, At, Bt) do { if constexpr (F8) PG8_MMA8(ai, bj, At, Bt); else PG8_MMA16(ai, bj, At, Bt); } while (0)
#define PG8_MMA8(ai, bj, At, Bt) do { __builtin_amdgcn_s_setprio(1); _Pragma("unroll") for (int m = 0; m < 4; ++m) _Pragma("unroll") for (int n = 0; n < 2; ++n) \
        asm volatile("v_mfma_scale_f32_16x16x128_f8f6f4 %0, %1, %2, %0, %3, %4 op_sel_hi:[0,0,0]" : "+v"(acc[ai][bj][m][n]) : "v"(Bt##8[n]), "v"(At##8[m]), "v"(sc_b), "v"(sc_a)); \
        __builtin_amdgcn_s_setprio(0); } while (0)
#define PG8_WAIT_V(n) asm volatile("s_waitcnt vmcnt(" #n ")" ::: "memory")
#define PG8_WAIT_L(n) asm volatile("s_waitcnt lgkmcnt(" #n ")" ::: "memory")
#define PG8_BAR __builtin_amdgcn_s_barrier()
#define PG8_SCHED __builtin_amdgcn_sched_barrier(0)
#define PG8_TOKOFF(dst, u) do { _Pragma("unroll") for (int _h = 0; _h < 2; ++_h) _Pragma("unroll") for (int _i = 0; _i < 2; ++_i) \
        dst[_h][_i] = (unsigned)P.rowidx[(u).pm * BM + _h * HALF + RA[_i]] * ldab + CA2[_i]; } while (0)
    Unit cur, nxt, nn; int ui = 0;
    if (!P.next(0, cur)) return;
    bool has_next = P.next(1, nxt);
    if constexpr (GA) { PG8_TOKOFF(vAc, cur); if (has_next) PG8_TOKOFF(vAn, nxt); else { vAn[0][0] = vAc[0][0]; vAn[0][1] = vAc[0][1]; vAn[1][0] = vAc[1][0]; vAn[1][1] = vAc[1][1]; } }
    f32x4 acc[2][2][4][2];
#pragma unroll
    for (int a = 0; a < 2; ++a)
#pragma unroll
        for (int b = 0; b < 2; ++b)
#pragma unroll
            for (int m = 0; m < 4; ++m)
#pragma unroll
                for (int n = 0; n < 2; ++n) acc[a][b][m][n] = (f32x4){0.f, 0.f, 0.f, 0.f};
    bf16x8 At[4][2], B0[2][2], B1[2][2]; v8i32 At8[4], B08[2], B18[2];
    const char* cA = P.a_base(cur); const char* cB = P.b_base(cur);
    if constexpr (SP2) {
        PG8_STAGE(PG8_SB(0, 0), cB, voffB); PG8_STAGE(PG8_SB(0, 1), cB + hstepB, voffB); PG8_STAGE(PG8_SA(0, 0), cA, vAc[0]); PG8_STAGE(PG8_SA(0, 1), cA, vAc[1]);
        if (wr == 1) PG8_BAR;
        PG8_WAIT_V(2); PG8_BAR;
        PG8_STAGE(PG8_SB(1, 0), cB + kstep, voffB); PG8_STAGE(PG8_SA(1, 0), cA + kstep, vAc[0]); PG8_STAGE(PG8_SB(1, 1), cB + hstepB + kstep, voffB);
        PG8_WAIT_V(6); PG8_BAR;
    } else {
        PG8_STAGE(PG8_SB(0, 0), cB, voffB); PG8_STAGE(PG8_SA(0, 0), cA, vAc[0]); PG8_STAGE(PG8_SB(0, 1), cB + hstepB, voffB); PG8_STAGE(PG8_SA(0, 1), cA, vAc[1]);
        if (wr == 1) PG8_BAR;
        PG8_WAIT_V(4); PG8_BAR;
        PG8_STAGE(PG8_SB(1, 0), cB + kstep, voffB); PG8_STAGE(PG8_SA(1, 0), cA + kstep, vAc[0]); PG8_STAGE(PG8_SB(1, 1), cB + hstepB + kstep, voffB);
        PG8_WAIT_V(6); PG8_BAR;
    }
    for (;;) {
        const bool has_nn = has_next && P.next(ui + 2, nn);
        const char* nA = has_next ? P.a_base(nxt) : cA; const char* nB = has_next ? P.b_base(nxt) : cB;
        for (int t = 0; t < nt; t += 2) {
            const bool last = (t == nt - 2);
            const char* a1 = cA + (size_t)(t + 1) * kstep;
            const char* a2 = last ? nA : cA + (size_t)(t + 2) * kstep; const char* b2 = last ? nB : cB + (size_t)(t + 2) * kstep;
            const char* a3 = a2 + kstep; const char* b3 = b2 + kstep;
            unsigned w0[2], w1[2];
#pragma unroll
            for (int i = 0; i < 2; ++i) { w0[i] = (GA && last) ? vAn[0][i] : vAc[0][i]; w1[i] = (GA && last) ? vAn[1][i] : vAc[1][i]; }
            if constexpr (SP2) {
            PG8_LDB(B0, 0, 0); PG8_LDB(B1, 0, 1); PG8_SCHED; PG8_LDA(At, 0, 0); PG8_STAGE(PG8_SA(1, 1), a1, vAc[1]);
            PG8_WAIT_V(8); PG8_WAIT_L(0); PG8_BAR; PG8_MMA(0, 0, At, B0); PG8_MMA(0, 1, At, B1); PG8_BAR; PG8_SCHED;
            PG8_LDA(At, 0, 1); PG8_STAGE(PG8_SB(0, 0), b2, voffB); PG8_STAGE(PG8_SB(0, 1), b2 + hstepB, voffB); PG8_STAGE(PG8_SA(0, 0), a2, w0);
            PG8_WAIT_V(8); PG8_WAIT_L(0); PG8_BAR; PG8_MMA(1, 0, At, B0); PG8_MMA(1, 1, At, B1); PG8_BAR; PG8_SCHED;
            PG8_LDB(B0, 1, 0); PG8_LDB(B1, 1, 1); PG8_SCHED; PG8_LDA(At, 1, 0); PG8_STAGE(PG8_SA(0, 1), a2, w1);
            PG8_WAIT_V(8); PG8_WAIT_L(0); PG8_BAR; PG8_MMA(0, 0, At, B0); PG8_MMA(0, 1, At, B1); PG8_BAR; PG8_SCHED;
            PG8_LDA(At, 1, 1); PG8_STAGE(PG8_SB(1, 0), b3, voffB); PG8_STAGE(PG8_SB(1, 1), b3 + hstepB, voffB); PG8_STAGE(PG8_SA(1, 0), a3, w0);
            PG8_WAIT_V(8); PG8_WAIT_L(0); PG8_BAR; PG8_MMA(1, 0, At, B0); PG8_MMA(1, 1, At, B1); PG8_BAR; PG8_SCHED;
            } else {
            PG8_LDB(B0, 0, 0); PG8_SCHED; PG8_LDA(At, 0, 0); PG8_STAGE(PG8_SA(1, 1), a1, vAc[1]);
            PG8_WAIT_L(8); PG8_BAR; PG8_WAIT_L(0); PG8_MMA(0, 0, At, B0); PG8_BAR; PG8_SCHED;
            PG8_LDB(B1, 0, 1); PG8_STAGE(PG8_SB(0, 0), b2, voffB);
            PG8_BAR; PG8_WAIT_L(0); PG8_MMA(0, 1, At, B1); PG8_BAR;
            PG8_LDA(At, 0, 1); PG8_STAGE(PG8_SA(0, 0), a2, w0);
            PG8_BAR; PG8_WAIT_L(0); PG8_MMA(1, 0, At, B0); PG8_BAR; PG8_SCHED;
            PG8_STAGE(PG8_SB(0, 1), b2 + hstepB, voffB);
            PG8_WAIT_V(6); PG8_BAR; PG8_MMA(1, 1, At, B1); PG8_BAR;
            PG8_LDB(B0, 1, 0); PG8_SCHED; PG8_LDA(At, 1, 0); PG8_STAGE(PG8_SA(0, 1), a2, w1);
            PG8_WAIT_L(8); PG8_BAR; PG8_WAIT_L(0); PG8_MMA(0, 0, At, B0); PG8_BAR; PG8_SCHED;
            PG8_LDB(B1, 1, 1); PG8_STAGE(PG8_SB(1, 0), b3, voffB);
            PG8_BAR; PG8_WAIT_L(0); PG8_MMA(0, 1, At, B1); PG8_BAR;
            PG8_LDA(At, 1, 1); PG8_STAGE(PG8_SA(1, 0), a3, w0);
            PG8_BAR; PG8_WAIT_L(0); PG8_MMA(1, 0, At, B0); PG8_BAR; PG8_SCHED;
            PG8_STAGE(PG8_SB(1, 1), b3 + hstepB, voffB);
            PG8_WAIT_V(6); PG8_BAR; PG8_MMA(1, 1, At, B1); PG8_BAR;
            }
        }
        if constexpr (ALIGN_EPI) { if (wr == 0) PG8_BAR; }
        if constexpr (F8) asm volatile("s_nop 15\n\ts_nop 15" ::: "memory");
        int tk[2][2] = {{0, 0}, {0, 0}};
        if constexpr (GA) { if (has_nn) {
#pragma unroll
            for (int h = 0; h < 2; ++h)
#pragma unroll
                for (int i = 0; i < 2; ++i) tk[h][i] = P.rowidx[nn.pm * BM + h * HALF + RA[i]]; }
            asm volatile("" ::: "memory"); }
        E(acc, cur, wr, wc, fr, fq);
        if (!has_next) break;
        if constexpr (GA) {
#pragma unroll
            for (int h = 0; h < 2; ++h)
#pragma unroll
                for (int i = 0; i < 2; ++i) { vAc[h][i] = vAn[h][i]; vAn[h][i] = has_nn ? (unsigned)tk[h][i] * ldab + CA2[i] : vAn[h][i]; } }
#pragma unroll
        for (int a = 0; a < 2; ++a)
#pragma unroll
            for (int b = 0; b < 2; ++b)
#pragma unroll
                for (int m = 0; m < 4; ++m)
#pragma unroll
                    for (int n = 0; n < 2; ++n) acc[a][b][m][n] = (f32x4){0.f, 0.f, 0.f, 0.f};
        cur = nxt; cA = nA; cB = nB; nxt = nn; has_next = has_nn; ++ui;
        if constexpr (ALIGN_EPI) { if (wr == 1) PG8_BAR; }
    }
    PG8_WAIT_V(0);
    if constexpr (!ALIGN_EPI) { if (wr == 0) PG8_BAR; }
    PG8_BAR;
#undef PG8_SA
#undef PG8_SB
#undef PG8_STAGE
#undef PG8_LDA
#undef PG8_LDB
#undef PG8_MMA
#undef PG8_MMA8
#undef PG8_MMA16
#undef PG8_WAIT_V
#undef PG8_WAIT_L
#undef PG8_BAR
#undef PG8_SCHED
#undef PG8_TOKOFF
}

typedef const f32x4 (&AccRef)[2][2][4][2];
__device__ __forceinline__ u32x4 pack8(f32x4 v0, f32x4 v1) { u32x4 w; w.x = cvt_pk_bf16(v0[0], v0[1]); w.y = cvt_pk_bf16(v0[2], v0[3]); w.z = cvt_pk_bf16(v1[0], v1[1]); w.w = cvt_pk_bf16(v1[2], v1[3]); return w; }
__device__ __forceinline__ unsigned pk4_fp8_(f32x4 v) { int w = 0; w = cvt2_fp8(v[0], v[1], w, false); w = cvt2_fp8(v[2], v[3], w, true); return (unsigned)w; }
__device__ __forceinline__ f32x4 sig4(f32x4 v) { return (f32x4){sigmoidf_(v[0]), sigmoidf_(v[1]), sigmoidf_(v[2]), sigmoidf_(v[3])}; }
__device__ __forceinline__ f32x4 swiglu4(f32x4 g, f32x4 u) { return (f32x4){siluf_(g[0]) * u[0], siluf_(g[1]) * u[1], siluf_(g[2]) * u[2], siluf_(g[3]) * u[3]}; }
__device__ __forceinline__ void unpack8(u32x4 w, f32x4& a, f32x4& b) { a = (f32x4){bf2f(w.x & 0xffffu), bf2f(w.x >> 16), bf2f(w.y & 0xffffu), bf2f(w.y >> 16)}; b = (f32x4){bf2f(w.z & 0xffffu), bf2f(w.z >> 16), bf2f(w.w & 0xffffu), bf2f(w.w >> 16)}; }

struct FEpiInProj { static constexpr bool PERM = true; bf16_t* Pj; float* KN2;
    __device__ __forceinline__ void operator()(AccRef acc, const Unit& u, int wr, int wc, int fr, int fq) const {
        const int mode = (u.pn == 0 || u.pn == 1 || u.pn == 3 || u.pn == 4) ? 1 : (u.pn >= 9 ? 2 : 0);
        const int row0 = u.pm * BM + wr * 64 + fr, col0 = u.pn * BM + wc * 32 + 8 * fq;
#pragma unroll
        for (int ai = 0; ai < 2; ++ai)
#pragma unroll
            for (int m = 0; m < 4; ++m) { bf16_t* rowp = Pj + (size_t)(row0 + ai * HALF + m * 16) * PC + col0;
#pragma unroll
                for (int bj = 0; bj < 2; ++bj) { f32x4 v0 = acc[ai][bj][m][0], v1 = acc[ai][bj][m][1];
                    if (mode == 1) { v0 = v0 * C2; v1 = v1 * C2; } else if (mode == 2) { v0 = sig4(v0); v1 = sig4(v1); }
                    const u32x4 w = pack8(v0, v1);
                    *(u32x4*)(rowp + bj * HALF) = w;
                    if (u.pn == 5 || u.pn == 6) {
                        f32x4 r0, r1; unpack8(w, r0, r1);
                        float ss = (r0[0] * r0[0] + r0[1] * r0[1]) + (r0[2] * r0[2] + r0[3] * r0[3]) + (r1[0] * r1[0] + r1[1] * r1[1]) + (r1[2] * r1[2] + r1[3] * r1[3]);
                        ss += __shfl_xor(ss, 16); ss += __shfl_xor(ss, 32);
                        if (fq == 0) atomicAdd(KN2 + (size_t)(row0 + ai * HALF + m * 16) * 8 + (u.pn - 5) * 4 + bj * 2 + (wc >> 1), ss); } } }
    } };
constexpr float MIX8_SCALE = 16.0f;
#define EPI_GLD16(dst, ptr) asm volatile("global_load_dwordx4 %0, %1, off" : "=v"(dst) : "v"(ptr) : "memory")
template <bool LAST> struct FEpiMix { static constexpr bool PERM = true; bf16_t* TMP; unsigned char* M8; const bf16_t* Pj; int gcol;
    __device__ __forceinline__ void operator()(AccRef acc, const Unit& u, int wr, int wc, int fr, int fq) const {
        const int row0 = u.pm * BM + wr * 64 + fr, col0 = u.pn * BM + wc * 32 + 8 * fq;
        u32x4 gv[2][2][2], tv[2][2][2];
#define MIX_LD(buf, k_) do { _Pragma("unroll") for (int mi = 0; mi < 2; ++mi) _Pragma("unroll") for (int bj = 0; bj < 2; ++bj) { \
            const size_t row_ = (size_t)(row0 + ((k_) >> 1) * HALF + (2 * ((k_) & 1) + mi) * 16); const int col_ = col0 + bj * HALF; \
            EPI_GLD16(gv[buf][mi][bj], Pj + row_ * PC + gcol + col_); if (LAST) EPI_GLD16(tv[buf][mi][bj], TMP + row_ * D + col_); } } while (0)
        MIX_LD(0, 0);
#pragma unroll
        for (int k = 0; k < 4; ++k) {
            const int cb = k & 1;
            if (k < 3) { if (cb == 0) MIX_LD(1, k + 1); else MIX_LD(0, k + 1); }
            if (k < 3) { if (LAST) asm volatile("s_waitcnt vmcnt(8)" ::: "memory"); else asm volatile("s_waitcnt vmcnt(4)" ::: "memory"); } else asm volatile("s_waitcnt vmcnt(0)" ::: "memory");
#pragma unroll
            for (int mi = 0; mi < 2; ++mi)
#pragma unroll
                for (int bj = 0; bj < 2; ++bj) { asm volatile("" : "+v"(gv[cb][mi][bj])); if (LAST) asm volatile("" : "+v"(tv[cb][mi][bj]));
                    const int ai = k >> 1, m = 2 * (k & 1) + mi; const size_t row = (size_t)(row0 + ai * HALF + m * 16); const int col = col0 + bj * HALF;
                    f32x4 g0, g1; unpack8(gv[cb][mi][bj], g0, g1);
                    f32x4 v0 = acc[ai][bj][m][0] * g0, v1 = acc[ai][bj][m][1] * g1;
                    if (LAST) { f32x4 m0, m1; unpack8(tv[cb][mi][bj], m0, m1); v0 = (v0 + m0) * MIX8_SCALE; v1 = (v1 + m1) * MIX8_SCALE;
                        *(u32x2*)(M8 + row * D + col) = (u32x2){pk4_fp8_(v0), pk4_fp8_(v1)}; }
                    else *(u32x4*)(TMP + row * D + col) = pack8(v0, v1); }
        }
#undef MIX_LD
    } };
struct FEpiRes { static constexpr bool PERM = false; float* O; const float* R;
    __device__ __forceinline__ void operator()(AccRef acc, const Unit& u, int wr, int wc, int fr, int fq) const {
        const int row0 = u.pm * BM + wr * 64 + fr, col0 = u.pn * BM + wc * 32 + 4 * fq;
#pragma unroll
        for (int ai = 0; ai < 2; ++ai)
#pragma unroll
            for (int m = 0; m < 4; ++m) { const size_t off = (size_t)(row0 + ai * HALF + m * 16) * D + col0;
#pragma unroll
                for (int bj = 0; bj < 2; ++bj)
#pragma unroll
                    for (int n = 0; n < 2; ++n) { const f32x4 r = *(const f32x4*)(R + off + bj * HALF + n * 16); *(f32x4*)(O + off + bj * HALF + n * 16) = r * ALPHA + acc[ai][bj][m][n]; } }
    } };
struct FEpiRS { static constexpr bool PERM = true; bf16_t* HSb; float* LG;
    __device__ __forceinline__ void operator()(AccRef acc, const Unit& u, int wr, int wc, int fr, int fq) const {
        const int row0 = u.pm * BM + wr * 64 + fr, c8 = wc * 32 + 8 * fq;
        if (u.pn < 2) {
#pragma unroll
            for (int ai = 0; ai < 2; ++ai)
#pragma unroll
                for (int m = 0; m < 4; ++m) { const size_t row = (size_t)(row0 + ai * HALF + m * 16);
                    *(u32x4*)(HSb + row * DS + u.pn * HALF + c8) = pack8(swiglu4(acc[ai][0][m][0], acc[ai][1][m][0]), swiglu4(acc[ai][0][m][1], acc[ai][1][m][1])); }
        } else {
#pragma unroll
            for (int ai = 0; ai < 2; ++ai)
#pragma unroll
                for (int m = 0; m < 4; ++m) { float* rp = LG + (size_t)(row0 + ai * HALF + m * 16) * NE + c8;
#pragma unroll
                    for (int bj = 0; bj < 2; ++bj)
#pragma unroll
                        for (int n = 0; n < 2; ++n) *(f32x4*)(rp + bj * HALF + 4 * n) = acc[ai][bj][m][n]; }
        }
    } };
struct FEpiRouter { static constexpr bool PERM = true; float* LG;
    __device__ __forceinline__ void operator()(AccRef acc, const Unit& u, int wr, int wc, int fr, int fq) const {
        const int row0 = u.pm * BM + wr * 64 + fr, c8 = wc * 32 + 8 * fq;
#pragma unroll
        for (int ai = 0; ai < 2; ++ai)
#pragma unroll
            for (int m = 0; m < 4; ++m) { float* rp = LG + (size_t)(row0 + ai * HALF + m * 16) * NE + c8;
#pragma unroll
                for (int bj = 0; bj < 2; ++bj)
#pragma unroll
                    for (int n = 0; n < 2; ++n) *(f32x4*)(rp + bj * HALF + 4 * n) = acc[ai][bj][m][n]; }
    } };
constexpr float HS8_SCALE = 8.0f;
struct FEpiShared8 { static constexpr bool PERM = true; unsigned char* Hb;
    __device__ __forceinline__ void operator()(AccRef acc, const Unit& u, int wr, int wc, int fr, int fq) const {
        const int row0 = u.pm * BM + wr * 64 + fr, c8 = wc * 32 + 8 * fq;
#pragma unroll
        for (int ai = 0; ai < 2; ++ai)
#pragma unroll
            for (int m = 0; m < 4; ++m) { const size_t row = (size_t)(row0 + ai * HALF + m * 16);
                *(u32x2*)(Hb + row * DS + u.pn * HALF + c8) = (u32x2){pk4_fp8_(swiglu4(acc[ai][0][m][0], acc[ai][1][m][0]) * HS8_SCALE), pk4_fp8_(swiglu4(acc[ai][0][m][1], acc[ai][1][m][1]) * HS8_SCALE)}; }
    } };
struct FEpiGU { static constexpr bool PERM = true; bf16_t* Hb;
    __device__ __forceinline__ void operator()(AccRef acc, const Unit& u, int wr, int wc, int fr, int fq) const {
        const int row0 = u.pm * BM + wr * 64 + fr, c8 = wc * 32 + 8 * fq;
#pragma unroll
        for (int ai = 0; ai < 2; ++ai)
#pragma unroll
            for (int m = 0; m < 4; ++m) { const size_t row = (size_t)(row0 + ai * HALF + m * 16);
                *(u32x4*)(Hb + row * DE + u.pn * HALF + c8) = pack8(swiglu4(acc[ai][0][m][0], acc[ai][1][m][0]), swiglu4(acc[ai][0][m][1], acc[ai][1][m][1])); }
    } };
constexpr float H8_SCALE = 32.0f;
struct FEpiGU8 { static constexpr bool PERM = true; unsigned char* Hb; const float* RW;
    __device__ __forceinline__ void operator()(AccRef acc, const Unit& u, int wr, int wc, int fr, int fq) const {
        const int row0 = u.pm * BM + wr * 64 + fr, c8 = wc * 32 + 8 * fq;
        float rw[2][4];
#pragma unroll
        for (int ai = 0; ai < 2; ++ai)
#pragma unroll
            for (int m = 0; m < 4; ++m) rw[ai][m] = RW[row0 + ai * HALF + m * 16];
#pragma unroll
        for (int ai = 0; ai < 2; ++ai)
#pragma unroll
            for (int m = 0; m < 4; ++m) { const size_t row = (size_t)(row0 + ai * HALF + m * 16); const float w = rw[ai][m] * H8_SCALE;
                *(u32x2*)(Hb + row * DE + u.pn * HALF + c8) = (u32x2){pk4_fp8_(swiglu4(acc[ai][0][m][0], acc[ai][1][m][0]) * w), pk4_fp8_(swiglu4(acc[ai][0][m][1], acc[ai][1][m][1]) * w)}; }
    } };
constexpr float Y8_SCALE = 16.0f;
__device__ __forceinline__ unsigned pk4_fp8(f32x4 v) { int w = 0; w = cvt2_fp8(v[0], v[1], w, false); w = cvt2_fp8(v[2], v[3], w, true); return (unsigned)w; }
struct FEpiDown { static constexpr bool PERM = true; unsigned char* Yb;
    __device__ __forceinline__ void operator()(AccRef acc, const Unit& u, int wr, int wc, int fr, int fq) const {
        const int row0 = u.pm * BM + wr * 64 + fr, col0 = u.pn * BM + wc * 32 + 8 * fq;
#pragma unroll
        for (int ai = 0; ai < 2; ++ai)
#pragma unroll
            for (int m = 0; m < 4; ++m) { const size_t row = (size_t)(row0 + ai * HALF + m * 16);
#pragma unroll
                for (int bj = 0; bj < 2; ++bj) *(u32x2*)(Yb + row * D + col0 + bj * HALF) = (u32x2){pk4_fp8(acc[ai][bj][m][0]), pk4_fp8(acc[ai][bj][m][1])}; }
    } };
struct FEpiPlain { static constexpr bool PERM = true; bf16_t* Ob;
    __device__ __forceinline__ void operator()(AccRef acc, const Unit& u, int wr, int wc, int fr, int fq) const {
        const int row0 = u.pm * BM + wr * 64 + fr, col0 = u.pn * BM + wc * 32 + 8 * fq;
#pragma unroll
        for (int ai = 0; ai < 2; ++ai)
#pragma unroll
            for (int m = 0; m < 4; ++m) { const size_t row = (size_t)(row0 + ai * HALF + m * 16);
#pragma unroll
                for (int bj = 0; bj < 2; ++bj) *(u32x4*)(Ob + row * D + col0 + bj * HALF) = pack8(acc[ai][bj][m][0], acc[ai][bj][m][1]); }
    } };
template <bool RF32> struct FEpiResB { static constexpr bool PERM = true; bf16_t* O; const void* R;
    __device__ __forceinline__ void operator()(AccRef acc, const Unit& u, int wr, int wc, int fr, int fq) const {
        const int row0 = u.pm * BM + wr * 64 + fr, col0 = u.pn * BM + wc * 32 + 8 * fq;
        u32x4 r0[2][2][2], r1[2][2][2];
#define RES_LD(buf, k_) do { _Pragma("unroll") for (int mi = 0; mi < 2; ++mi) _Pragma("unroll") for (int bj = 0; bj < 2; ++bj) { \
            const size_t off_ = (size_t)(row0 + ((k_) >> 1) * HALF + (2 * ((k_) & 1) + mi) * 16) * D + col0 + bj * HALF; \
            if (RF32) { EPI_GLD16(r0[buf][mi][bj], (const float*)R + off_); EPI_GLD16(r1[buf][mi][bj], (const float*)R + off_ + 4); } else EPI_GLD16(r0[buf][mi][bj], (const bf16_t*)R + off_); } } while (0)
        RES_LD(0, 0);
#pragma unroll
        for (int k = 0; k < 4; ++k) {
            const int cb = k & 1;
            if (k < 3) { if (cb == 0) RES_LD(1, k + 1); else RES_LD(0, k + 1); }
            if (k < 3) { if (RF32) asm volatile("s_waitcnt vmcnt(8)" ::: "memory"); else asm volatile("s_waitcnt vmcnt(4)" ::: "memory"); } else asm volatile("s_waitcnt vmcnt(0)" ::: "memory");
#pragma unroll
            for (int mi = 0; mi < 2; ++mi)
#pragma unroll
                for (int bj = 0; bj < 2; ++bj) { asm volatile("" : "+v"(r0[cb][mi][bj])); if (RF32) asm volatile("" : "+v"(r1[cb][mi][bj]));
                    const int ai = k >> 1, m = 2 * (k & 1) + mi; const size_t off = (size_t)(row0 + ai * HALF + m * 16) * D + col0 + bj * HALF;
                    f32x4 a0, a1;
                    if (RF32) { a0 = __builtin_bit_cast(f32x4, r0[cb][mi][bj]); a1 = __builtin_bit_cast(f32x4, r1[cb][mi][bj]); } else unpack8(r0[cb][mi][bj], a0, a1);
                    *(u32x4*)(O + off) = pack8(a0 * ALPHA + acc[ai][bj][m][0], a1 * ALPHA + acc[ai][bj][m][1]); }
        }
#undef RES_LD
    } };
}

__device__ __forceinline__ void cvt_item(const float* W, int ldw, int col0, int k0, bf16* WT, int ldd, int row0, LAS float* scr, int lane) {
#pragma unroll 8
    for (int i = 0; i < 32; ++i) { const int kk = 2 * i + (lane >> 5); scr[kk * 33 + (lane & 31)] = W[(size_t)(k0 + kk) * ldw + col0 + (lane & 31)]; }
    asm volatile("s_waitcnt lgkmcnt(0)" ::: "memory");
    const int c = lane & 7;
#pragma unroll
    for (int j = 0; j < 4; ++j) { const int n = (lane >> 3) + 8 * j; const LAS float* s = scr + (8 * c) * 33 + n;
        u32x4 o; o.x = pk2(s[0 * 33], s[1 * 33]); o.y = pk2(s[2 * 33], s[3 * 33]); o.z = pk2(s[4 * 33], s[5 * 33]); o.w = pk2(s[6 * 33], s[7 * 33]);
        *(u32x4*)(WT + (size_t)(row0 + n) * ldd + k0 + 8 * c) = o; }
    asm volatile("s_waitcnt lgkmcnt(0)" ::: "memory");
}

__device__ __forceinline__ void cvt_load(float (&r)[32], const float* src, int ldw, int lane) {
#pragma unroll
    for (int i = 0; i < 32; ++i) r[i] = src[(size_t)(2 * i + (lane >> 5)) * ldw + (lane & 31)];
}
__device__ __forceinline__ void cvt_store(const float (&r)[32], bf16* dst, int ldd, LAS float* scr, int lane) {
#pragma unroll
    for (int i = 0; i < 32; ++i) scr[(2 * i + (lane >> 5)) * 33 + (lane & 31)] = r[i];
    asm volatile("s_waitcnt lgkmcnt(0)" ::: "memory");
    const int c = lane & 7;
#pragma unroll
    for (int j = 0; j < 4; ++j) { const int n = (lane >> 3) + 8 * j; const LAS float* s = scr + (8 * c) * 33 + n;
        u32x4 o; o.x = pk2(s[0 * 33], s[1 * 33]); o.y = pk2(s[2 * 33], s[3 * 33]); o.z = pk2(s[4 * 33], s[5 * 33]); o.w = pk2(s[6 * 33], s[7 * 33]);
        *(u32x4*)(dst + (size_t)n * ldd + 8 * c) = o; }
    asm volatile("s_waitcnt lgkmcnt(0)" ::: "memory");
}

__device__ __forceinline__ void cvt_load4(f32x4 (&r)[8], const float* src, int ldw, int lane) {
#pragma unroll
    for (int i = 0; i < 8; ++i) r[i] = *(const f32x4*)(src + (size_t)(8 * i + (lane >> 3)) * ldw + 4 * (lane & 7));
}
__device__ __forceinline__ void cvt_store4(const f32x4 (&r)[8], bf16* dst, int ldd, LAS float* scr, int lane) {
#pragma unroll
    for (int i = 0; i < 8; ++i) { LAS float* d = scr + (8 * i + (lane >> 3)) * 33 + 4 * (lane & 7); d[0] = r[i][0]; d[1] = r[i][1]; d[2] = r[i][2]; d[3] = r[i][3]; }
    asm volatile("s_waitcnt lgkmcnt(0)" ::: "memory");
    const int c = lane & 7;
#pragma unroll
    for (int j = 0; j < 4; ++j) { const int n = (lane >> 3) + 8 * j; const LAS float* s = scr + (8 * c) * 33 + n;
        u32x4 o; o.x = pk2(s[0 * 33], s[1 * 33]); o.y = pk2(s[2 * 33], s[3 * 33]); o.z = pk2(s[4 * 33], s[5 * 33]); o.w = pk2(s[6 * 33], s[7 * 33]);
        *(u32x4*)(dst + (size_t)n * ldd + 8 * c) = o; }
    asm volatile("s_waitcnt lgkmcnt(0)" ::: "memory");
}

constexpr float W8_SCALE = 64.0f;
__device__ __forceinline__ void cvt_store4_f8(const f32x4 (&r)[8], unsigned char* dst, int ldd, LAS float* scr, int lane) {
#pragma unroll
    for (int i = 0; i < 8; ++i) { LAS float* d = scr + (8 * i + (lane >> 3)) * 33 + 4 * (lane & 7); d[0] = r[i][0]; d[1] = r[i][1]; d[2] = r[i][2]; d[3] = r[i][3]; }
    asm volatile("s_waitcnt lgkmcnt(0)" ::: "memory");
    const int c = lane & 7;
#pragma unroll
    for (int j = 0; j < 4; ++j) { const int n = (lane >> 3) + 8 * j; const LAS float* s = scr + (8 * c) * 33 + n;
        int w0 = 0, w1 = 0;
        w0 = cvt2_fp8(s[0 * 33] * W8_SCALE, s[1 * 33] * W8_SCALE, w0, false); w0 = cvt2_fp8(s[2 * 33] * W8_SCALE, s[3 * 33] * W8_SCALE, w0, true);
        w1 = cvt2_fp8(s[4 * 33] * W8_SCALE, s[5 * 33] * W8_SCALE, w1, false); w1 = cvt2_fp8(s[6 * 33] * W8_SCALE, s[7 * 33] * W8_SCALE, w1, true);
        *(u32x2*)(dst + (size_t)n * ldd + 8 * c) = (u32x2){(unsigned)w0, (unsigned)w1}; }
    asm volatile("s_waitcnt lgkmcnt(0)" ::: "memory");
}

__device__ __forceinline__ void cvt_item_f8(const float* W, int ldw, int col0, int k0, unsigned char* WT, int ldd, int row0, LAS float* scr, int lane) {
#pragma unroll 8
    for (int i = 0; i < 32; ++i) { const int kk = 2 * i + (lane >> 5); scr[kk * 33 + (lane & 31)] = W[(size_t)(k0 + kk) * ldw + col0 + (lane & 31)]; }
    asm volatile("s_waitcnt lgkmcnt(0)" ::: "memory");
    const int c = lane & 7;
#pragma unroll
    for (int j = 0; j < 4; ++j) { const int n = (lane >> 3) + 8 * j; const LAS float* s = scr + (8 * c) * 33 + n;
        int w0 = 0, w1 = 0;
        w0 = cvt2_fp8(s[0 * 33] * W8_SCALE, s[1 * 33] * W8_SCALE, w0, false); w0 = cvt2_fp8(s[2 * 33] * W8_SCALE, s[3 * 33] * W8_SCALE, w0, true);
        w1 = cvt2_fp8(s[4 * 33] * W8_SCALE, s[5 * 33] * W8_SCALE, w1, false); w1 = cvt2_fp8(s[6 * 33] * W8_SCALE, s[7 * 33] * W8_SCALE, w1, true);
        *(u32x2*)(WT + (size_t)(row0 + n) * ldd + k0 + 8 * c) = (u32x2){(unsigned)w0, (unsigned)w1}; }
    asm volatile("s_waitcnt lgkmcnt(0)" ::: "memory");
}
namespace attn_body {
typedef unsigned short bf16;
using bf16x8=__attribute__((ext_vector_type(8)))short;
using s16x4=__attribute__((ext_vector_type(4)))short;
using f32x16=__attribute__((ext_vector_type(16)))float;
using u32x4=__attribute__((ext_vector_type(4)))unsigned;
constexpr int BATCH=4,NHEAD=8,SEQ=8192,D=64,DM=4352,OP=512;
constexpr int NW=8,QBLK=32,QB=QBLK*NW,KVBLK=64,NQB=SEQ/QB;
constexpr int ATTN_UNIT_ROWS=QB;
__device__ __forceinline__ int crow(int r,int hi){return (r&3)+8*(r>>2)+4*hi;}
#define SBAR() __builtin_amdgcn_sched_barrier(0)
__device__ __forceinline__ void cmask(f32x16&p0,f32x16&p1,int jb,int qrel,int hi){
  const float NEG=-INFINITY; int kb=64*jb+4*hi;
  #pragma unroll
  for(int r=0;r<16;++r){int kv=kb+(r&3)+8*(r>>2); if(kv>qrel)p0[r]=NEG; if(kv+32>qrel)p1[r]=NEG;}
}

constexpr int NSLOT=3, SLOTB=8192;
constexpr int LDS_K=0, LDS_V=NSLOT*SLOTB, LDS_WS=2*NSLOT*SLOTB, LDS_OST=LDS_WS+NW*64*4, LDS_KB=LDS_OST+NW*4096, LDS_BYTES=LDS_KB+4*256;
constexpr float O8_SCALE=16.0f;
constexpr int SKIP_LDS=LDS_BYTES;
constexpr float C2=0.125f*1.4426950408889634f;
__device__ __forceinline__ void glds16(const void*gsrc,unsigned lds_dst){unsigned keep;
  asm volatile("s_mov_b32 %0, m0\n\ts_mov_b32 m0, %2\n\ts_nop 0\n\tglobal_load_lds_dwordx4 %1, off\n\ts_mov_b32 m0, %0":"=&s"(keep):"v"(gsrc),"s"(lds_dst):"memory");}
__device__ __forceinline__ void glds4(const void*gsrc,unsigned lds_dst){unsigned keep;
  asm volatile("s_mov_b32 %0, m0\n\ts_mov_b32 m0, %2\n\ts_nop 0\n\tglobal_load_lds_dword %1, off\n\ts_mov_b32 m0, %0":"=&s"(keep):"v"(gsrc),"s"(lds_dst):"memory");}
__device__ __forceinline__ float max3f(float a,float b,float c){float r;asm("v_max3_f32 %0, %1, %2, %3":"=v"(r):"v"(a),"v"(b),"v"(c));return r;}
__device__ __forceinline__ float max2f(float a,float b){float r;asm("v_max_f32_e32 %0, %1, %2":"=v"(r):"v"(a),"v"(b));return r;}
__device__ __forceinline__ float fadd_s(float a,float b){float r;asm("v_add_f32_e32 %0, %1, %2":"=v"(r):"v"(a),"v"(b));return r;}
__device__ __forceinline__ float fsub_s(float a,float b){float r;asm("v_sub_f32_e32 %0, %1, %2":"=v"(r):"v"(a),"v"(b));return r;}
typedef float f32x2_t __attribute__((ext_vector_type(2))); typedef __bf16 bf16x2_t __attribute__((ext_vector_type(2)));
__device__ __forceinline__ unsigned cvtpk_s(float lo,float hi){f32x2_t v={lo,hi};bf16x2_t b=__builtin_convertvector(v,bf16x2_t);return __builtin_bit_cast(unsigned,b);}
#define WAIT_BAR(N) asm volatile("s_waitcnt vmcnt(" #N ") lgkmcnt(0)\n\ts_barrier":::"memory")

__device__ __forceinline__ void qkt(f32x16&p0,f32x16&p1,const char*Kslot,const bf16x8*qr,int r32,int hi){
  const char*kb=Kslot+hi*1024+r32*16;
  #pragma unroll
  for(int d0=0;d0<4;++d0){
    const bf16x8 b0=*reinterpret_cast<const bf16x8*>(kb+d0*2048);
    const bf16x8 b1=*reinterpret_cast<const bf16x8*>(kb+d0*2048+512);
    p0=__builtin_amdgcn_mfma_f32_32x32x16_bf16(b0,qr[d0],p0,0,0,0);p1=__builtin_amdgcn_mfma_f32_32x32x16_bf16(b1,qr[d0],p1,0,0,0);}
}
typedef __attribute__((address_space(3))) const char* lds_cptr;
typedef short v4i16_t __attribute__((ext_vector_type(4)));
__device__ __forceinline__ void kload8(bf16x8*kf,lds_cptr kp){
  kf[0]=*(const __attribute__((address_space(3))) bf16x8*)(kp);      kf[1]=*(const __attribute__((address_space(3))) bf16x8*)(kp+512);
  kf[2]=*(const __attribute__((address_space(3))) bf16x8*)(kp+2048); kf[3]=*(const __attribute__((address_space(3))) bf16x8*)(kp+2560);
  kf[4]=*(const __attribute__((address_space(3))) bf16x8*)(kp+4096); kf[5]=*(const __attribute__((address_space(3))) bf16x8*)(kp+4608);
  kf[6]=*(const __attribute__((address_space(3))) bf16x8*)(kp+6144); kf[7]=*(const __attribute__((address_space(3))) bf16x8*)(kp+6656);
}
__device__ __forceinline__ void kload2(bf16x8*kf,lds_cptr kp,int j){ kf[2*j]=*(const __attribute__((address_space(3))) bf16x8*)(kp+j*2048); kf[2*j+1]=*(const __attribute__((address_space(3))) bf16x8*)(kp+j*2048+512); }
__device__ __forceinline__ s16x4 vtr(lds_cptr p){ return __builtin_bit_cast(s16x4,__builtin_amdgcn_ds_read_tr16_b64_v4i16((__attribute__((address_space(3))) v4i16_t*)p)); }
__device__ __forceinline__ float rowmax(const f32x16&p0,const f32x16&p1){
  float a=max3f(p0[0],p0[1],p1[0]),b=max3f(p0[2],p0[3],p1[1]);a=max3f(a,p1[2],p1[3]);
  #pragma unroll
  for(int r=4;r<16;r+=4){a=max3f(a,p0[r],p0[r+1]);b=max3f(b,p0[r+2],p0[r+3]);a=max3f(a,p1[r],p1[r+1]);b=max3f(b,p1[r+2],p1[r+3]);}
  const float m=max2f(a,b);
  auto rr=__builtin_amdgcn_permlane32_swap(__float_as_uint(m),__float_as_uint(m),false,false);
  return max2f(__uint_as_float(rr[0]),__uint_as_float(rr[1]));
}
__device__ __forceinline__ void pv(f32x16*o,int vb,bf16x8 pa0,bf16x8 pa1,bf16x8 pa2,bf16x8 pa3){
  #pragma unroll
  for(int d0=0;d0<2;++d0){s16x4 lo[4],hi[4];
    #pragma unroll
    for(int ks=0;ks<4;++ks){
      asm volatile("ds_read_b64_tr_b16 %0,%1 offset:%c2":"=&v"(lo[ks]):"v"(vb),"i"(d0*4096+ks*1024):"memory");
      asm volatile("ds_read_b64_tr_b16 %0,%1 offset:%c2":"=&v"(hi[ks]):"v"(vb),"i"(d0*4096+ks*1024+512):"memory");}
    asm volatile("s_waitcnt lgkmcnt(0)":::"memory");SBAR();
    #define PK(k) (bf16x8){lo[k][0],lo[k][1],lo[k][2],lo[k][3],hi[k][0],hi[k][1],hi[k][2],hi[k][3]}
    o[d0]=__builtin_amdgcn_mfma_f32_32x32x16_bf16(pa0,PK(0),o[d0],0,0,0);
    o[d0]=__builtin_amdgcn_mfma_f32_32x32x16_bf16(pa1,PK(1),o[d0],0,0,0);
    o[d0]=__builtin_amdgcn_mfma_f32_32x32x16_bf16(pa2,PK(2),o[d0],0,0,0);
    o[d0]=__builtin_amdgcn_mfma_f32_32x32x16_bf16(pa3,PK(3),o[d0],0,0,0);
    #undef PK
  }
}

#ifndef ATTN_STORE16
#define ATTN_STORE16(p,v) (*(u32x4*)(p)=(v))
#endif
template<int THRL> __device__ __forceinline__ void attn_unit(int tid,int b,int h,int qb,const bf16*Q,const bf16*__restrict__ K,const bf16*__restrict__ V,const float*__restrict__ KB,const float*__restrict__ KN2,bf16*O,char*shm){
  const int lane=tid&63,r32=lane&31,hi=lane>>5; const int wid=__builtin_amdgcn_readfirstlane(tid>>6);
  const long rowbase=(long)b*SEQ; const int q0=qb*QB;
  const bf16*Qw=Q+(rowbase+q0+wid*QBLK)*DM+h*D;
  bf16x8 qr[4];
  #pragma unroll
  for(int d0=0;d0<4;++d0)qr[d0]=*reinterpret_cast<const bf16x8*>(&Qw[(long)r32*DM+d0*16+hi*8]);
  int T0=0;
  { const int NTf=(q0+QB)/KVBLK;
    if(NTf>4){
      __attribute__((address_space(3))) float* wmx=(__attribute__((address_space(3))) float*)((const __attribute__((address_space(3))) char*)shm+SKIP_LDS);
      __attribute__((address_space(3))) int* tst=(__attribute__((address_space(3))) int*)(wmx+8);
      float ss=0.f;
      #pragma unroll
      for(int d0=0;d0<4;++d0)
        #pragma unroll
        for(int e=0;e<8;++e){const float x=__uint_as_float(((unsigned)(unsigned short)qr[d0][e])<<16); ss+=x*x;}
      {auto rr=__builtin_amdgcn_permlane32_swap(__float_as_uint(ss),__float_as_uint(ss),false,false);ss=__uint_as_float(rr[0])+__uint_as_float(rr[1]);}
      const float wm=wave_max_all(ss);
      if(lane==0)wmx[wid]=wm; if(tid==0)*tst=NTf-4;
      asm volatile("s_waitcnt lgkmcnt(0)\n\ts_barrier":::"memory");
      float q2=wmx[0];
      #pragma unroll
      for(int w=1;w<8;++w)q2=__builtin_fmaxf(q2,wmx[w]);
      const int tile=tid>>2, quarter=tid&3;
      if(tile<NTf-4){
        const float*kn=KN2+((rowbase+(long)tile*64+quarter*16)*8+h); float m2=0.f;
        #pragma unroll
        for(int i=0;i<16;++i)m2=__builtin_fmaxf(m2,kn[i*8]);
        m2=__builtin_fmaxf(m2,dpp_f<0xB1>(m2)); m2=__builtin_fmaxf(m2,dpp_f<0x4E>(m2));
        const float*kbh=KB+(long)(b*NHEAD+h)*SEQ;
        const float bound=sqrtf(q2*m2)*1.01f+kbh[tile*64+63]-kbh[q0];
        if(quarter==0&&!(bound<-152.f))__hip_atomic_fetch_min(tst,tile,__ATOMIC_RELAXED,__HIP_MEMORY_SCOPE_WORKGROUP);
      }
      asm volatile("s_waitcnt vmcnt(0) lgkmcnt(0)\n\ts_barrier":::"memory");
      T0=__builtin_amdgcn_readfirstlane(*tst)&~1;
    } }
  const bf16*Kh=K+(rowbase+(long)T0*KVBLK)*DM+h*D,*Vh=V+(rowbase+(long)T0*KVBLK)*DM+h*D;
  const unsigned lds0=(unsigned)(uintptr_t)shm; const __attribute__((address_space(3))) char* shm3_=(const __attribute__((address_space(3))) char*)shm;
  float*wsf=(float*)(shm+LDS_WS)+wid*64;
  const bf16*ksrc=Kh+(long)lane*DM+wid*8;
  const bf16*vsrc=Vh+(long)(16*(wid&3)+(lane>>2))*DM+(wid>>2)*32+(lane&3)*8;
  const unsigned kdst=lds0+LDS_K+wid*1024, vdst=lds0+LDS_V+wid*1024;
  const float*bsrc=KB+(long)(b*NHEAD+h)*SEQ+T0*KVBLK+lane; const unsigned bdst=lds0+LDS_KB;
  #define DMA_K(t,slot) do{ glds4(bsrc+(long)(t)*KVBLK,(unsigned)__builtin_amdgcn_readfirstlane(bdst+(((t)&3)<<8))); glds16(ksrc+(long)(t)*KVBLK*DM,(unsigned)__builtin_amdgcn_readfirstlane(kdst+(slot))); }while(0)
  #define DMA_V(t,slot) glds16(vsrc+(long)(t)*KVBLK*DM,(unsigned)__builtin_amdgcn_readfirstlane(vdst+(slot)))
  const int vb0=(int)(lds0+LDS_V)+((lane>>4)&1)*32+(lane&3)*8+(4*hi+((lane&15)>>2))*64;
  const char*Kbase=shm+LDS_K; bf16x8 kf[8];
  const lds_cptr shm3=(lds_cptr)shm; const lds_cptr kp0=shm3+LDS_K+hi*1024+r32*16; const lds_cptr vp0=shm3+LDS_V+((lane>>4)&1)*32+(lane&3)*8+(4*hi+((lane&15)>>2))*64;
  const int NT=(q0+QB)/KVBLK-T0;
  DMA_K(0,0);DMA_V(0,0);DMA_K(1,SLOTB);
  float mhat=KB[(long)(b*NHEAD+h)*SEQ+q0+wid*QBLK+r32],l_reg=0.f;f32x16 o[2];o[0]=f32x16{};o[1]=f32x16{};
  typedef __attribute__((address_space(3))) const float* lds_fptr; typedef float f32x4_t __attribute__((ext_vector_type(4)));
  const lds_fptr kbp=(lds_fptr)(shm3_+LDS_KB+hi*16);
  #define CINIT(C0,C1,t) do{ const lds_fptr bs_=kbp+(((t)&3)<<6); const float nm_=-mhat; \
    _Pragma("unroll") for(int g_=0;g_<4;++g_){ const f32x4_t x0_=*(const __attribute__((address_space(3))) f32x4_t*)(bs_+8*g_), x1_=*(const __attribute__((address_space(3))) f32x4_t*)(bs_+32+8*g_); \
      C0[4*g_]=x0_[0]+nm_;C0[4*g_+1]=x0_[1]+nm_;C0[4*g_+2]=x0_[2]+nm_;C0[4*g_+3]=x0_[3]+nm_; C1[4*g_]=x1_[0]+nm_;C1[4*g_+1]=x1_[1]+nm_;C1[4*g_+2]=x1_[2]+nm_;C1[4*g_+3]=x1_[3]+nm_; } }while(0)
  const int qrel=wid*QBLK+r32;
  #define CMASK(P0,P1,t) do{int jb_=(t)-(NT-4); if(jb_>=0)cmask(P0,P1,jb_,qrel,hi);}while(0)
  bool resc=false;
  #define START(P0,P1) do{ const float rm=rowmax(P0,P1); resc=false; \
    { const float dl=max2f(rm,0.f); mhat=fadd_s(mhat,dl); \
      _Pragma("unroll") for(int r=0;r<16;++r){P0[r]=fsub_s(P0[r],dl);P1[r]=fsub_s(P1[r],dl);} } \
    _Pragma("unroll") for(int r=0;r<16;++r)P0[r]=__builtin_amdgcn_exp2f(P0[r]); }while(0)
  #define RESC() do{ if(resc){ asm volatile("s_waitcnt lgkmcnt(0)":::"memory"); \
      _Pragma("unroll") for(int d_=0;d_<2;++d_) _Pragma("unroll") for(int r=0;r<16;++r)o[d_][r]*=wsf[crow(r,hi)]; } }while(0)
  f32x16 pA0,pA1,pB0,pB1;
  int sl_prev=0,sl_cur=0,sl_next=SLOTB;
  #define ROT() do{sl_prev=sl_cur;sl_cur=sl_next;sl_next=(sl_next==(NSLOT-1)*SLOTB)?0:sl_next+SLOTB;}while(0)
  DMA_K(2,2*SLOTB);
  WAIT_BAR(5);
  CINIT(pA0,pA1,0);
  qkt(pA0,pA1,Kbase,qr,r32,hi);asm volatile("s_nop 15\n\ts_nop 7":"+v"(pA0),"+v"(pA1));CMASK(pA0,pA1,0);
  START(pA0,pA1);
  _Pragma("unroll") for(int r=0;r<16;++r)pA1[r]=__builtin_amdgcn_exp2f(pA1[r]);
  WAIT_BAR(0);
  DMA_K(3,0);DMA_V(1,SLOTB);
  ROT();
  kload8(kf,kp0+sl_cur);
  WAIT_BAR(3);
  s16x4 vlo[8],vhi[8]; u32x4 pw0,pw1,pw2,pw3;
  #define PKW(P,B) cvtpk_s(P[B],P[B+1])
  #define PAF(k) __builtin_bit_cast(bf16x8,pw##k)
  #define VFR(i) (bf16x8){vlo[i][0],vlo[i][1],vlo[i][2],vlo[i][3],vhi[i][0],vhi[i][1],vhi[i][2],vhi[i][3]}
  #define PIN(x) asm volatile("":"+v"(x))
  #define MX3(a,b,c) __builtin_fmaxf(__builtin_fmaxf((a),(b)),(c))
  #define GAPA(MF,A0,A1,A2,A3,W0,W1,PW) do{ MF; sacc+=A0; sacc+=A1; sacc+=A2; sacc+=A3; PIN(sacc); W0; W1; PIN(PW); SBAR(); }while(0)
  #define EX(v) __builtin_amdgcn_exp2f(v)
  #define GAPB(MF,X,B) do{ MF; X[B]=EX(X[B]); X[B+1]=EX(X[B+1]); X[B+2]=EX(X[B+2]); X[B+3]=EX(X[B+3]); PIN(X); SBAR(); }while(0)
  #define VRD(i) do{ vlo[i]=vtr(vp_+(((i)>>2)*4096+((i)&3)*1024)); vhi[i]=vtr(vp_+(((i)>>2)*4096+((i)&3)*1024+512)); }while(0)
  #define KRD(G,j) do{ if(G){ kload2(kf,kp0+sl_next,j); SBAR(); } }while(0)
  #define STEP(C0,C1,P0,P1,t,GK,GV,GL) do{ SBAR(); \
    const lds_cptr vp_=vp0+sl_prev; \
    CINIT(C0,C1,t); SBAR(); \
    VRD(0); SBAR(); float sacc=(P0[0]+P0[1]); \
    GAPA(C0=__builtin_amdgcn_mfma_f32_32x32x16_bf16(kf[0],qr[0],C0,0,0,0), P0[2],P0[3],P0[4],P0[5],     pw0[0]=PKW(P0,0), pw0[1]=PKW(P0,2), pw0); \
    VRD(4); SBAR(); GAPA(C1=__builtin_amdgcn_mfma_f32_32x32x16_bf16(kf[1],qr[0],C1,0,0,0), P0[6],P0[7],P0[8],P0[9],     pw0[2]=PKW(P0,4), pw0[3]=PKW(P0,6), pw0); \
    VRD(1); SBAR(); GAPA(C0=__builtin_amdgcn_mfma_f32_32x32x16_bf16(kf[2],qr[1],C0,0,0,0),   P0[10],P0[11],P0[12],P0[13], pw1[0]=PKW(P0,8), pw1[1]=PKW(P0,10), pw1); \
    VRD(5); SBAR(); GAPA(C1=__builtin_amdgcn_mfma_f32_32x32x16_bf16(kf[3],qr[1],C1,0,0,0),   P0[14],P0[15],P1[0],P1[1],   pw1[2]=PKW(P0,12),pw1[3]=PKW(P0,14), pw1); \
    VRD(2); SBAR(); GAPA(C0=__builtin_amdgcn_mfma_f32_32x32x16_bf16(kf[4],qr[2],C0,0,0,0),   P1[2],P1[3],P1[4],P1[5],     pw2[0]=PKW(P1,0), pw2[1]=PKW(P1,2), pw2); \
    VRD(6); SBAR(); GAPA(C1=__builtin_amdgcn_mfma_f32_32x32x16_bf16(kf[5],qr[2],C1,0,0,0),   P1[6],P1[7],P1[8],P1[9],     pw2[2]=PKW(P1,4), pw2[3]=PKW(P1,6), pw2); \
    VRD(3); SBAR(); GAPA(C0=__builtin_amdgcn_mfma_f32_32x32x16_bf16(kf[6],qr[3],C0,0,0,0),   P1[10],P1[11],P1[12],P1[13], pw3[0]=PKW(P1,8), pw3[1]=PKW(P1,10), pw3); \
    VRD(7); SBAR(); GAPA(C1=__builtin_amdgcn_mfma_f32_32x32x16_bf16(kf[7],qr[3],C1,0,0,0),   P1[14],P1[15],0.f,0.f,       pw3[2]=PKW(P1,12),pw3[3]=PKW(P1,14), pw3); \
    l_reg+=sacc; \
    if(GK){DMA_K((t)+3,sl_cur);} if(GV){DMA_V((t)+1,sl_next);} \
    CMASK(C0,C1,t); \
    { float a=MX3(C0[0],C0[1],C1[0]),b=MX3(C0[2],C0[3],C1[1]); a=MX3(a,C1[2],C1[3]); \
      _Pragma("unroll") for(int r=4;r<16;r+=4){a=MX3(a,C0[r],C0[r+1]);b=MX3(b,C0[r+2],C0[r+3]);a=MX3(a,C1[r],C1[r+1]);b=MX3(b,C1[r+2],C1[r+3]);} \
      float rm=__builtin_fmaxf(a,b); { auto rr=__builtin_amdgcn_permlane32_swap(__float_as_uint(rm),__float_as_uint(rm),false,false); rm=__builtin_fmaxf(__uint_as_float(rr[0]),__uint_as_float(rr[1])); } \
      resc=false; \
      if(__builtin_expect(__any(rm>(float)THRL),0)){ const float dl=__builtin_fmaxf(rm,0.f); mhat+=dl; \
        _Pragma("unroll") for(int r=0;r<16;++r){C0[r]-=dl;C1[r]-=dl;} \
        const float f=__builtin_amdgcn_exp2f(-dl); l_reg*=f; if(hi==0)wsf[r32]=f; resc=true; } } \
    SBAR(); \
    GAPB(o[0]=__builtin_amdgcn_mfma_f32_32x32x16_bf16(PAF(0),VFR(0),o[0],0,0,0), C0,0); \
    GAPB(o[1]=__builtin_amdgcn_mfma_f32_32x32x16_bf16(PAF(0),VFR(4),o[1],0,0,0), C0,4); \
    KRD(GL,0); GAPB(o[0]=__builtin_amdgcn_mfma_f32_32x32x16_bf16(PAF(1),VFR(1),o[0],0,0,0), C0,8); \
    KRD(GL,1); GAPB(o[1]=__builtin_amdgcn_mfma_f32_32x32x16_bf16(PAF(1),VFR(5),o[1],0,0,0), C0,12); \
    KRD(GL,2); GAPB(o[0]=__builtin_amdgcn_mfma_f32_32x32x16_bf16(PAF(2),VFR(2),o[0],0,0,0), C1,0); \
    KRD(GL,3); GAPB(o[1]=__builtin_amdgcn_mfma_f32_32x32x16_bf16(PAF(2),VFR(6),o[1],0,0,0), C1,4); \
    GAPB(o[0]=__builtin_amdgcn_mfma_f32_32x32x16_bf16(PAF(3),VFR(3),o[0],0,0,0), C1,8); \
    GAPB(o[1]=__builtin_amdgcn_mfma_f32_32x32x16_bf16(PAF(3),VFR(7),o[1],0,0,0), C1,12); \
    }while(0)
  int t=1;
  #undef CMASK
  #define CMASK(P0,P1,t) do{}while(0)
  for(;t+5<NT;t+=2){
    STEP(pB0,pB1,pA0,pA1,t,true,true,true);     WAIT_BAR(3); RESC(); ROT();
    STEP(pA0,pA1,pB0,pB1,t+1,true,true,true);   WAIT_BAR(3); RESC(); ROT();
  }
  #undef CMASK
  #define CMASK(P0,P1,t) do{int jb_=(t)-(NT-4); if(jb_>=0)cmask(P0,P1,jb_,qrel,hi);}while(0)
  #define ENDW(tt) do{ if((tt)+3<NT){WAIT_BAR(3);} else if((tt)+2<NT){WAIT_BAR(1);} else {WAIT_BAR(0);} }while(0)
  for(;t+1<NT;t+=2){
    STEP(pB0,pB1,pA0,pA1,t,(t+3<NT),(t+1<NT),(t+1<NT));       ENDW(t);   RESC(); ROT();
    STEP(pA0,pA1,pB0,pB1,t+1,(t+4<NT),(t+2<NT),(t+2<NT));     ENDW(t+1); RESC(); ROT();
  }
  STEP(pB0,pB1,pA0,pA1,NT-1,false,false,false); RESC();
  { float sacc=pB0[0]+pB0[1]; _Pragma("unroll") for(int r=2;r<16;++r)sacc+=pB0[r]; _Pragma("unroll") for(int r=0;r<16;++r)sacc+=pB1[r]; l_reg+=sacc;
    pw0=(u32x4){PKW(pB0,0),PKW(pB0,2),PKW(pB0,4),PKW(pB0,6)};pw1=(u32x4){PKW(pB0,8),PKW(pB0,10),PKW(pB0,12),PKW(pB0,14)};pw2=(u32x4){PKW(pB1,0),PKW(pB1,2),PKW(pB1,4),PKW(pB1,6)};pw3=(u32x4){PKW(pB1,8),PKW(pB1,10),PKW(pB1,12),PKW(pB1,14)};
    SBAR(); pv(o,vb0+sl_cur,PAF(0),PAF(1),PAF(2),PAF(3)); }
  #undef PKW
  #undef PAF
  #undef VFR
  #undef PIN
  #undef MX3
  #undef GAPA
  #undef GAPB
  #undef EX
  #undef VRD
  #undef KRD
  #undef STEP
  #undef ENDW
  {auto rr=__builtin_amdgcn_permlane32_swap(__float_as_uint(l_reg),__float_as_uint(l_reg),false,false);l_reg=__uint_as_float(rr[0])+__uint_as_float(rr[1]);}
  if(hi==0)wsf[32+r32]=l_reg;asm volatile("s_waitcnt lgkmcnt(0)":::"memory");
  float rli[16];
  #pragma unroll
  for(int r=0;r<16;++r)rli[r]=__builtin_amdgcn_rcpf(wsf[32+crow(r,hi)]);
  unsigned char*Ow=(unsigned char*)O+(rowbase+q0+wid*QBLK)*OP+h*D;
  { unsigned char*stg=(unsigned char*)(shm+LDS_OST)+wid*2048;
    #pragma unroll
    for(int r=0;r<16;++r){const int orow=crow(r,hi); const float sc_=rli[r]*O8_SCALE;
      const int w_=cvt2_fp8(o[0][r]*sc_,o[1][r]*sc_,0,false);
      stg[orow*64+r32]=(unsigned char)w_; stg[orow*64+32+r32]=(unsigned char)(w_>>8);}
    asm volatile("s_waitcnt lgkmcnt(0)":::"memory");
    #pragma unroll
    for(int i=0;i<2;++i){const int row=i*16+(lane>>2),ch=lane&3; const u32x4 v=*(const u32x4*)(stg+row*64+ch*16); ATTN_STORE16(Ow+(long)row*OP+ch*16,v);} }
  asm volatile("s_waitcnt lgkmcnt(0)\n\ts_barrier":::"memory");
  #undef DMA_K
  #undef CINIT
  #undef DMA_V
  #undef CMASK
  #undef START
  #undef RESC
  #undef ROT
}

constexpr int SWA_TAB=SKIP_LDS+64;
constexpr int SWA_LDS_BYTES=SWA_TAB+2*4*256*4;
__device__ __forceinline__ void swa_tables(int tid,const float*relb,const unsigned char*bucket,char*shm){
  __attribute__((address_space(3))) float* tab=(__attribute__((address_space(3))) float*)((const __attribute__((address_space(3))) char*)shm+SWA_TAB);
  #pragma unroll
  for(int k=0;k<4;++k){ const int idx=tid+512*k, hq=idx>>8, e=(idx&255)-64; tab[idx]=(e>=0&&e<128)?relb[(int)bucket[e]*8+hq]*1.4426950408889634f:-INFINITY; }
}
__device__ __forceinline__ void swa_unit(int tid,int b,int kvh,int qt,const bf16*Q,const bf16*__restrict__ K,const bf16*__restrict__ V,const float*sinks,bf16*O,char*shm){
  const int lane=tid&63,r32=lane&31,hi=lane>>5; const int wid=__builtin_amdgcn_readfirstlane(tid>>6);
  const int h4=wid>>1, hq=kvh*4+h4, qhalf=wid&1;
  const long rowbase=(long)b*SEQ; const int q0=qt*64;
  const bf16*Qw=Q+(rowbase+q0+qhalf*32)*DM+hq*D;
  const bf16*Kh=K+rowbase*DM+kvh*D,*Vh=V+rowbase*DM+kvh*D;
  const unsigned lds0=(unsigned)(uintptr_t)shm; const __attribute__((address_space(3))) char* shm3_=(const __attribute__((address_space(3))) char*)shm;
  float*wsf=(float*)(shm+LDS_WS)+wid*64;
  const int kt_lo=qt>=2?qt-2:0, ntile=qt-kt_lo+1;
  const bf16*ksrc=Kh+(long)lane*DM+wid*8;
  const bf16*vsrc=Vh+(long)(16*(wid&3)+(lane>>2))*DM+(wid>>2)*32+(lane&3)*8;
  const unsigned kdst=lds0+LDS_K+wid*1024, vdst=lds0+LDS_V+wid*1024;
  #pragma unroll
  for(int j=0;j<3;++j) if(j<ntile){ glds16(ksrc+(long)(kt_lo+j)*KVBLK*DM,(unsigned)__builtin_amdgcn_readfirstlane(kdst+j*SLOTB)); glds16(vsrc+(long)(kt_lo+j)*KVBLK*DM,(unsigned)__builtin_amdgcn_readfirstlane(vdst+j*SLOTB)); }
  bf16x8 qr[4];
  #pragma unroll
  for(int d0=0;d0<4;++d0)qr[d0]=*reinterpret_cast<const bf16x8*>(&Qw[(long)r32*DM+d0*16+hi*8]);
  const float sink2=sinks[hq]*1.4426950408889634f;
  WAIT_BAR(0);
  const char*Kbase=shm+LDS_K;
  const __attribute__((address_space(3))) float* tabh=(const __attribute__((address_space(3))) float*)(shm3_+SWA_TAB)+(kvh*4+h4)*256+64;
  const int tq=q0+qhalf*32+r32;
  const float NEG=-INFINITY;
  f32x16 p[3][2];
  float mx=NEG;
  #pragma unroll
  for(int j=0;j<3;++j){
    if(j<ntile){
      p[j][0]=f32x16{};p[j][1]=f32x16{};
      qkt(p[j][0],p[j][1],Kbase+j*SLOTB,qr,r32,hi);
      const int kb=(kt_lo+j)*64+4*hi;
      #pragma unroll
      for(int r=0;r<16;++r){ const int kv=kb+(r&3)+8*(r>>2); const int d0_=tq-kv;
        p[j][0][r]+=tabh[d0_]; p[j][1][r]+=tabh[d0_-32];
        mx=__builtin_fmaxf(mx,__builtin_fmaxf(p[j][0][r],p[j][1][r])); }
    } else {
      #pragma unroll
      for(int r=0;r<16;++r){p[j][0][r]=NEG;p[j][1][r]=NEG;} }
  }
  { auto rr=__builtin_amdgcn_permlane32_swap(__float_as_uint(mx),__float_as_uint(mx),false,false); mx=__builtin_fmaxf(__uint_as_float(rr[0]),__uint_as_float(rr[1])); }
  mx=__builtin_fmaxf(mx,sink2);
  float l_reg=0.f;
  #pragma unroll
  for(int j=0;j<3;++j)
    #pragma unroll
    for(int r=0;r<16;++r){ p[j][0][r]=__builtin_amdgcn_exp2f(p[j][0][r]-mx); p[j][1][r]=__builtin_amdgcn_exp2f(p[j][1][r]-mx); l_reg+=p[j][0][r]+p[j][1][r]; }
  f32x16 o[2];o[0]=f32x16{};o[1]=f32x16{};
  const int vb0=(int)(lds0+LDS_V)+((lane>>4)&1)*32+(lane&3)*8+(4*hi+((lane&15)>>2))*64;
  #define PKW(P,B) cvtpk_s(P[B],P[B+1])
  #pragma unroll
  for(int j=0;j<3;++j) if(j<ntile){
    u32x4 pw0=(u32x4){PKW(p[j][0],0),PKW(p[j][0],2),PKW(p[j][0],4),PKW(p[j][0],6)},pw1=(u32x4){PKW(p[j][0],8),PKW(p[j][0],10),PKW(p[j][0],12),PKW(p[j][0],14)};
    u32x4 pw2=(u32x4){PKW(p[j][1],0),PKW(p[j][1],2),PKW(p[j][1],4),PKW(p[j][1],6)},pw3=(u32x4){PKW(p[j][1],8),PKW(p[j][1],10),PKW(p[j][1],12),PKW(p[j][1],14)};
    SBAR(); pv(o,vb0+j*SLOTB,__builtin_bit_cast(bf16x8,pw0),__builtin_bit_cast(bf16x8,pw1),__builtin_bit_cast(bf16x8,pw2),__builtin_bit_cast(bf16x8,pw3)); }
  #undef PKW
  {auto rr=__builtin_amdgcn_permlane32_swap(__float_as_uint(l_reg),__float_as_uint(l_reg),false,false);l_reg=__uint_as_float(rr[0])+__uint_as_float(rr[1]);}
  l_reg+=__builtin_amdgcn_exp2f(sink2-mx);
  if(hi==0)wsf[32+r32]=l_reg;asm volatile("s_waitcnt lgkmcnt(0)":::"memory");
  float rli[16];
  #pragma unroll
  for(int r=0;r<16;++r)rli[r]=__builtin_amdgcn_rcpf(wsf[32+crow(r,hi)]);
  unsigned char*Ow=(unsigned char*)O+(rowbase+q0+qhalf*32)*OP+hq*D;
  { unsigned char*stg=(unsigned char*)(shm+LDS_OST)+wid*2048;
    #pragma unroll
    for(int r=0;r<16;++r){const int orow=crow(r,hi); const float sc_=rli[r]*O8_SCALE;
      const int w_=cvt2_fp8(o[0][r]*sc_,o[1][r]*sc_,0,false);
      stg[orow*64+r32]=(unsigned char)w_; stg[orow*64+32+r32]=(unsigned char)(w_>>8);}
    asm volatile("s_waitcnt lgkmcnt(0)":::"memory");
    #pragma unroll
    for(int i=0;i<2;++i){const int row=i*16+(lane>>2),ch=lane&3; const u32x4 v=*(const u32x4*)(stg+row*64+ch*16); ATTN_STORE16(Ow+(long)row*OP+ch*16,v);} }
  asm volatile("s_waitcnt lgkmcnt(0)\n\ts_barrier":::"memory");
}
constexpr int ATTN_LDS_BYTES=SWA_LDS_BYTES;
struct AttnTensors { const unsigned char* base; long oQ, oK, oV, oKB, oKN2, oO; };
struct AttnUnit { int bh; int qb; };
struct StaticOrder {
  int vcu;
  __device__ __forceinline__ explicit StaticOrder(int grid,int block):vcu((block%8)*(grid/8)+block/8){}
  __device__ __forceinline__ bool next(int i,AttnUnit&u)const{ if(i>=4)return false; const int s=vcu&7; u.bh=vcu>>3; u.qb=(i==0)?s:(i==1)?15-s:(i==2)?16+s:31-s; return true; }
  __device__ __forceinline__ void a_ready(const AttnUnit&)const{}
  __device__ __forceinline__ void done(const AttnUnit&)const{}
};
struct SnakeOrder {
  int na, v;
  __device__ __forceinline__ SnakeOrder(int na_,int v_):na(na_),v(v_){}
  __device__ __forceinline__ bool next(int i,AttnUnit&u)const{ const int j=i*na+((i&1)?na-1-v:v); if(j>=32*NQB)return false; u.bh=j&31; u.qb=NQB-1-(j>>5); return true; }
  __device__ __forceinline__ void a_ready(const AttnUnit&)const{}
  __device__ __forceinline__ void done(const AttnUnit&)const{}
};
struct QueueOrder {
  unsigned* head; __attribute__((address_space(3))) int* slot; int tid;
  __device__ __forceinline__ bool next(int i,AttnUnit&u)const{
    if(tid==0)slot[i&1]=(int)__hip_atomic_fetch_add(head,1u,__ATOMIC_RELAXED,__HIP_MEMORY_SCOPE_AGENT);
    asm volatile("s_waitcnt vmcnt(0) lgkmcnt(0)\n\ts_barrier":::"memory");
    const int j=__builtin_amdgcn_readfirstlane(slot[i&1]); if(j>=32*NQB)return false; u.bh=j&31; u.qb=NQB-1-(j>>5); return true; }
  __device__ __forceinline__ void a_ready(const AttnUnit&)const{}
  __device__ __forceinline__ void done(const AttnUnit&)const{}
};
template<class Sched,int THRL=8> __device__ __forceinline__ void attn_phase(int tid,char*lds,const AttnTensors&T,const Sched&S){
  AttnUnit u;
  for(int i=0;S.next(i,u);++i){ const unsigned char* wb=T.base; asm volatile("":"+s"(wb)); const __attribute__((address_space(1))) unsigned char* gb=(const __attribute__((address_space(1))) unsigned char*)wb;
    int tid2=tid; asm volatile("":"+v"(tid2));
    attn_unit<THRL>(tid2,u.bh/NHEAD,u.bh%NHEAD,u.qb,(const bf16*)(gb+T.oQ),(const bf16*)(gb+T.oK),(const bf16*)(gb+T.oV),(const float*)(gb+T.oKB),(const float*)(gb+T.oKN2),(bf16*)(gb+T.oO),lds); }
}
#undef SBAR
#undef WAIT_BAR
}

struct Args { const float* in[20]; float* out; unsigned char* ws; int ph_lo, ph_hi; };
enum { I_X = 0, I_WIN, I_BF, I_SINK, I_RELB, I_WPA, I_WPB, I_WOUT, I_LN1G, I_LN1B, I_WR, I_RB, I_WGE, I_WUE, I_WDE, I_WGS, I_WUS, I_WDS, I_LN2G, I_LN2B };
enum { PH_CVT = 0, PH_INPROJ, PH_ATTN, PH_PROJ, PH_OUT, PH_LN1, PH_RS, PH_ROUTE, PH_OFFS, PH_GU, PH_DOWN, PH_LN2, NPH };
static_assert(NCHUNK == NE, "PH_OFFS: block c owns chunk c and expert c");

struct NGemm {
    const bf16* A; int lda; const int* ridx;
    const float* B; const float* B2; int ldb;
    int K; int bskip_at, bskip;
};
template <bool DUAL, class Epi>
__device__ __forceinline__ void ngemm_tile(const NGemm& g, int row0, int col0, LAS float* lds, const Epi& epi) {
    const int tid = threadIdx.x;
    LAS float* As = lds; LAS float* Bs = lds + 16 * 132; LAS float* Bs2 = Bs + 16 * 128;
    const int ty = tid >> 5, tx = tid & 31;
    float acc[8][4], acc2[8][4];
#pragma unroll
    for (int i = 0; i < 8; ++i)
#pragma unroll
        for (int j = 0; j < 4; ++j) { acc[i][j] = 0.f; acc2[i][j] = 0.f; }
    const int ar = tid >> 2, akq = (tid & 3) * 4;
    const int arow = g.ridx ? g.ridx[row0 + ar] : row0 + ar;
    const bf16* ap = g.A + (size_t)arow * g.lda + akq;
    const int bk = tid >> 5, bn = (tid & 31) * 4;
    int scol = col0 + bn; scol += (scol >= g.bskip_at) ? g.bskip : 0;
    const float* bp = g.B + (size_t)bk * g.ldb + scol;
    const float* bp2 = DUAL ? g.B2 + (size_t)bk * g.ldb + scol : nullptr;
    for (int k0 = 0; k0 < g.K; k0 += 16) {
        const u32x2 av = *(const u32x2*)(ap + k0);
        const f32x4 bv = *(const f32x4*)(bp + (size_t)k0 * g.ldb);
        f32x4 bv2 = (f32x4){0.f, 0.f, 0.f, 0.f};
        if (DUAL) bv2 = *(const f32x4*)(bp2 + (size_t)k0 * g.ldb);
        __syncthreads();
        As[(akq + 0) * 132 + ar] = bf2f(av.x & 0xffffu); As[(akq + 1) * 132 + ar] = bf2f(av.x >> 16);
        As[(akq + 2) * 132 + ar] = bf2f(av.y & 0xffffu); As[(akq + 3) * 132 + ar] = bf2f(av.y >> 16);
        *(LAS f32x4*)(Bs + bk * 128 + bn) = bv;
        if (DUAL) *(LAS f32x4*)(Bs2 + bk * 128 + bn) = bv2;
        __syncthreads();
#pragma unroll 2
        for (int kk = 0; kk < 16; ++kk) {
            const f32x4 a0 = *(const LAS f32x4*)(As + kk * 132 + ty * 8), a1 = *(const LAS f32x4*)(As + kk * 132 + ty * 8 + 4);
            const f32x4 b = *(const LAS f32x4*)(Bs + kk * 128 + tx * 4);
            const float a[8] = {a0.x, a0.y, a0.z, a0.w, a1.x, a1.y, a1.z, a1.w};
#pragma unroll
            for (int i = 0; i < 8; ++i) { acc[i][0] += a[i] * b.x; acc[i][1] += a[i] * b.y; acc[i][2] += a[i] * b.z; acc[i][3] += a[i] * b.w; }
            if (DUAL) {
                const f32x4 b2 = *(const LAS f32x4*)(Bs2 + kk * 128 + tx * 4);
#pragma unroll
                for (int i = 0; i < 8; ++i) { acc2[i][0] += a[i] * b2.x; acc2[i][1] += a[i] * b2.y; acc2[i][2] += a[i] * b2.z; acc2[i][3] += a[i] * b2.w; }
            }
        }
    }
#pragma unroll
    for (int i = 0; i < 8; ++i)
        epi(row0 + ty * 8 + i, col0 + tx * 4, (f32x4){acc[i][0], acc[i][1], acc[i][2], acc[i][3]}, (f32x4){acc2[i][0], acc2[i][1], acc2[i][2], acc2[i][3]});
    __syncthreads();
}

struct EpiInProj { bf16* P;
    __device__ __forceinline__ void operator()(int row, int col, f32x4 a, f32x4) const {
        if (col < PC_AK || (col >= PC_BQ && col < PC_BK)) a = a * C2;
        else if (col >= PC_GA) { a.x = sigmoidf_(a.x); a.y = sigmoidf_(a.y); a.z = sigmoidf_(a.z); a.w = sigmoidf_(a.w); }
        *(u32x2*)(P + (size_t)row * PC + col) = (u32x2){pk2(a.x, a.y), pk2(a.z, a.w)}; } };
struct EpiMix { bf16* MIXB; const bf16* P; int gcol; bool add;
    __device__ __forceinline__ void operator()(int row, int col, f32x4 a, f32x4) const {
        const u32x2 gv = *(const u32x2*)(P + (size_t)row * PC + gcol + col);
        f32x4 r = (f32x4){bf2f(gv.x & 0xffffu) * a.x, bf2f(gv.x >> 16) * a.y, bf2f(gv.y & 0xffffu) * a.z, bf2f(gv.y >> 16) * a.w};
        bf16* mp = MIXB + (size_t)row * D + col;
        if (add) { const u32x2 mv = *(const u32x2*)mp; r.x += bf2f(mv.x & 0xffffu); r.y += bf2f(mv.x >> 16); r.z += bf2f(mv.y & 0xffffu); r.w += bf2f(mv.y >> 16); }
        *(u32x2*)mp = (u32x2){pk2(r.x, r.y), pk2(r.z, r.w)}; } };
struct EpiRes { float* O; const float* R;
    __device__ __forceinline__ void operator()(int row, int col, f32x4 a, f32x4) const {
        const f32x4 r = *(const f32x4*)(R + (size_t)row * D + col);
        *(f32x4*)(O + (size_t)row * D + col) = r * ALPHA + a; } };
struct EpiF32 { float* O; int ldo;
    __device__ __forceinline__ void operator()(int row, int col, f32x4 a, f32x4) const { *(f32x4*)(O + (size_t)row * ldo + col) = a; } };
struct EpiSwiglu { bf16* O; int ldo;
    __device__ __forceinline__ void operator()(int row, int col, f32x4 g, f32x4 u) const {
        *(u32x2*)(O + (size_t)row * ldo + col) = (u32x2){pk2(siluf_(g.x) * u.x, siluf_(g.y) * u.y), pk2(siluf_(g.z) * u.z, siluf_(g.w) * u.w)}; } };
struct EpiDown { bf16* Y; const float* RW;
    __device__ __forceinline__ void operator()(int row, int col, f32x4 a, f32x4) const {
        const float w = RW[row]; *(u32x2*)(Y + (size_t)row * D + col) = (u32x2){pk2(a.x * w, a.y * w), pk2(a.z * w, a.w * w)}; } };

template <bool SWA>
__device__ __forceinline__ void nattn_unit(int tid, int b, int h, int qt, const bf16* Pj, const float* Cc, const float* relb, float sinkv, bf16* O, LAS float* lds) {
    const int qi = tid >> 3, sub = tid & 7;
    const int t = qt * 64 + qi;
    const size_t row = (size_t)b * SEQ + t;
    const int qcol = SWA ? PC_AQ + h * 64 : PC_BQ + h * 64;
    const int kcol = SWA ? PC_AK + (h >> 2) * 64 : PC_BK + h * 64;
    const int vcol = SWA ? PC_AV + (h >> 2) * 64 : PC_BV + h * 64;
    float q[8], o[8];
    { const u32x4 v = *(const u32x4*)(Pj + row * PC + qcol + sub * 8);
      q[0] = bf2f(v.x & 0xffffu); q[1] = bf2f(v.x >> 16); q[2] = bf2f(v.y & 0xffffu); q[3] = bf2f(v.y >> 16);
      q[4] = bf2f(v.z & 0xffffu); q[5] = bf2f(v.z >> 16); q[6] = bf2f(v.w & 0xffffu); q[7] = bf2f(v.w >> 16); }
    const float cq = SWA ? 0.f : Cc[row * 8 + h];
    LAS float* Ks = lds; LAS float* Vs = lds + 64 * 68; LAS float* Cs = Vs + 64 * 68;
    float m = -1e30f, l = 0.f;
#pragma unroll
    for (int d = 0; d < 8; ++d) o[d] = 0.f;
    const int kt_lo = SWA ? (qt >= 2 ? qt - 2 : 0) : 0;
    for (int kt = kt_lo; kt <= qt; ++kt) {
        __syncthreads();
        { const int key = tid >> 3, d8 = (tid & 7) * 8; const size_t krow = (size_t)b * SEQ + kt * 64 + key;
          const u32x4 kv = *(const u32x4*)(Pj + krow * PC + kcol + d8), vv = *(const u32x4*)(Pj + krow * PC + vcol + d8);
          LAS float* kd = Ks + key * 68 + d8; LAS float* vd = Vs + key * 68 + d8;
          *(LAS f32x4*)kd = (f32x4){bf2f(kv.x & 0xffffu), bf2f(kv.x >> 16), bf2f(kv.y & 0xffffu), bf2f(kv.y >> 16)};
          *(LAS f32x4*)(kd + 4) = (f32x4){bf2f(kv.z & 0xffffu), bf2f(kv.z >> 16), bf2f(kv.w & 0xffffu), bf2f(kv.w >> 16)};
          *(LAS f32x4*)vd = (f32x4){bf2f(vv.x & 0xffffu), bf2f(vv.x >> 16), bf2f(vv.y & 0xffffu), bf2f(vv.y >> 16)};
          *(LAS f32x4*)(vd + 4) = (f32x4){bf2f(vv.z & 0xffffu), bf2f(vv.z >> 16), bf2f(vv.w & 0xffffu), bf2f(vv.w >> 16)};
          if (!SWA && (tid & 7) == 0) Cs[key] = Cc[krow * 8 + h]; }
        __syncthreads();
#pragma unroll 2
        for (int j = 0; j < 64; ++j) {
            const int s = kt * 64 + j;
            const f32x4 k0 = *(const LAS f32x4*)(Ks + j * 68 + sub * 8), k1 = *(const LAS f32x4*)(Ks + j * 68 + sub * 8 + 4);
            float dot = q[0] * k0.x + q[1] * k0.y + q[2] * k0.z + q[3] * k0.w + q[4] * k1.x + q[5] * k1.y + q[6] * k1.z + q[7] * k1.w;
            dot += __shfl_xor(dot, 1); dot += __shfl_xor(dot, 2); dot += __shfl_xor(dot, 4);
            const int dist = t - s;
            const bool valid = (dist >= 0) && (!SWA || dist < WIN);
            float bias;
            if (SWA) { const int dc = dist < 0 ? 0 : (dist > 127 ? 127 : dist); bias = relb[(int)T5_BUCKET[dc] * 8 + h] * LOG2E; }
            else bias = (cq - Cs[j]) * LOG2E;
            const float sc = valid ? dot + bias : -1e30f;
            const float mnew = fmaxf(m, sc), al = exp2f(m - mnew), p = valid ? exp2f(sc - mnew) : 0.f;
            l = l * al + p; m = mnew;
            const f32x4 v0 = *(const LAS f32x4*)(Vs + j * 68 + sub * 8), v1 = *(const LAS f32x4*)(Vs + j * 68 + sub * 8 + 4);
            o[0] = o[0] * al + p * v0.x; o[1] = o[1] * al + p * v0.y; o[2] = o[2] * al + p * v0.z; o[3] = o[3] * al + p * v0.w;
            o[4] = o[4] * al + p * v1.x; o[5] = o[5] * al + p * v1.y; o[6] = o[6] * al + p * v1.z; o[7] = o[7] * al + p * v1.w;
        }
    }
    float r = 1.f, denom = l;
    if (SWA) { const float sk = sinkv * LOG2E, Mf = fmaxf(m, sk); r = exp2f(m - Mf); denom = l * r + exp2f(sk - Mf); }
    const float inv = r / denom;
    *(u32x4*)(O + row * 512 + h * 64 + sub * 8) = (u32x4){pk2(o[0] * inv, o[1] * inv), pk2(o[2] * inv, o[3] * inv), pk2(o[4] * inv, o[5] * inv), pk2(o[6] * inv, o[7] * inv)};
}

__device__ __forceinline__ void route_token(int t, const float* LG, f32x4 rb, int* TE, float* TW, LAS int* hist, int lane) {
    const f32x4 lg = *(const f32x4*)(LG + (size_t)t * NE + lane * 4);
    float sc[4] = {sigmoidf_(lg.x), sigmoidf_(lg.y), sigmoidf_(lg.z), sigmoidf_(lg.w)};
    float bi[4] = {sc[0] + rb.x, sc[1] + rb.y, sc[2] + rb.z, sc[3] + rb.w};
    float a1 = fmaxf(bi[0], bi[1]), a2 = fminf(bi[0], bi[1]);
#pragma unroll
    for (int i = 2; i < 4; ++i) { const float v = bi[i]; const float n1 = fmaxf(a1, v), n2 = fmaxf(a2, fminf(a1, v)); a1 = n1; a2 = n2; }
    { float b1 = dpp_f<0xB1>(a1), b2 = dpp_f<0xB1>(a2); float n1 = fmaxf(a1, b1), n2 = fmaxf(fminf(a1, b1), fmaxf(a2, b2)); a1 = n1; a2 = n2;
      b1 = dpp_f<0x4E>(a1); b2 = dpp_f<0x4E>(a2); n1 = fmaxf(a1, b1); n2 = fmaxf(fminf(a1, b1), fmaxf(a2, b2)); a1 = n1; a2 = n2;
      b1 = dpp_f<0x141>(a1); b2 = dpp_f<0x141>(a2); n1 = fmaxf(a1, b1); n2 = fmaxf(fminf(a1, b1), fmaxf(a2, b2)); a1 = n1; a2 = n2; }
    const float gs = a1 + a2; const int mygrp = lane >> 3; int rank = 0;
#pragma unroll
    for (int g = 0; g < NG; ++g) { const float v = rdlane_f(gs, g * 8); rank += (v > gs || (v == gs && g < mygrp)) ? 1 : 0; }
    const bool sel = rank < TOPG;
    const float NEG = -__builtin_inff();
    float cv[4];
#pragma unroll
    for (int i = 0; i < 4; ++i) cv[i] = sel ? bi[i] : NEG;
    int my_e = 0; float my_w = 0.f, tot = 0.f;
#pragma unroll
    for (int r = 0; r < TOPK; ++r) {
        const float vmax = wave_max_all(fmaxf(fmaxf(cv[0], cv[1]), fmaxf(cv[2], cv[3])));
        int id = 1 << 20;
#pragma unroll
        for (int i = 0; i < 4; ++i) { const unsigned long long bl = __ballot(cv[i] == vmax); const int c = bl ? (int)__builtin_ctzll(bl) * 4 + i : (1 << 20); id = c < id ? c : id; }
        const int el = id & 3, ow = id >> 2;
        const float ssel = el == 0 ? sc[0] : (el == 1 ? sc[1] : (el == 2 ? sc[2] : sc[3]));
        const float wsc = rdlane_f(ssel, ow);
        tot += wsc;
        if (lane == r) { my_e = id; my_w = wsc; }
#pragma unroll
        for (int i = 0; i < 4; ++i) if (lane == ow && i == el) cv[i] = NEG;
    }
    if (lane < TOPK) { TE[(size_t)t * TOPK + lane] = my_e; TW[(size_t)t * TOPK + lane] = my_w / tot * ROUTED_SCALE; __hip_atomic_fetch_add(hist + my_e, 1, __ATOMIC_RELAXED, __HIP_MEMORY_SCOPE_WORKGROUP); }
}

__device__ __forceinline__ void ln_row(f32x4 (&v)[4], const float* g, const float* bta, int lane) {
    float s = 0.f;
#pragma unroll
    for (int j = 0; j < 4; ++j) s += (v[j].x + v[j].y) + (v[j].z + v[j].w);
    const float mean = wave_sum(s) * (1.f / D); float s2 = 0.f;
#pragma unroll
    for (int j = 0; j < 4; ++j) { v[j] = v[j] - mean; s2 += (v[j].x * v[j].x + v[j].y * v[j].y) + (v[j].z * v[j].z + v[j].w * v[j].w); }
    const float rstd = 1.f / sqrtf(wave_sum(s2) * (1.f / D) + LN_EPS);
#pragma unroll
    for (int j = 0; j < 4; ++j) { const f32x4 gg = *(const f32x4*)(g + lane * 4 + 256 * j), bb = *(const f32x4*)(bta + lane * 4 + 256 * j); v[j] = v[j] * rstd * gg + bb; }
}

#ifndef REP_CVT
#define REP_CVT 1
#endif
#ifndef REP_INPROJ
#define REP_INPROJ 1
#endif
#ifndef REP_ATTN
#define REP_ATTN 1
#endif
#ifndef REP_PROJA
#define REP_PROJA 1
#endif
#ifndef REP_OUT
#define REP_OUT 1
#endif
#ifndef REP_LN1
#define REP_LN1 1
#endif
#ifndef REP_RS
#define REP_RS 1
#endif
#ifndef REP_ROUTE
#define REP_ROUTE 1
#endif
#ifndef REP_OFFS
#define REP_OFFS 1
#endif
#ifndef REP_GU
#define REP_GU 1
#endif
#ifndef REP_DOWN
#define REP_DOWN 1
#endif
#ifndef REP_LN2
#define REP_LN2 1
#endif
#ifndef REP_SWA
#define REP_SWA 1
#endif
#ifndef REP_CONV
#define REP_CONV 1
#endif
#ifndef REP_ATTN
#define REP_ATTN 1
#endif
#define IN(k) (lo <= (k) && (k) < hi)
#define SEAM(k) do { if (IN(k) && IN((k) + 1)) xcd_barrier(bar); } while (0)
#define PHASE_WS unsigned char* wsp_ = args.ws; asm volatile("" : "+s"(wsp_)); GAS unsigned char* WSP = (GAS unsigned char*)wsp_; int tid = (wave0 << 6) | lane_id_opaque(); \
        const int lane = tid & 63, wave = __builtin_amdgcn_readfirstlane(tid >> 6), gw = bid * NWAVES + wave; (void)lane; (void)gw
#define LOGF ((float*)(WSP + WS_LOGF))
#define CC ((float*)(WSP + WS_C))
#define CKB ((float*)(WSP + WS_CKB))
#define KN2 ((float*)(WSP + WS_KN2))
#define TOPE ((int*)(WSP + WS_TOPE))
#define TOPW ((float*)(WSP + WS_TOPW))
#define INV ((int*)(WSP + WS_INV))
#define ROWTOK ((int*)(WSP + WS_ROWTOK))
#define ROWW ((float*)(WSP + WS_ROWW))
#define CNT ((int*)(WSP + WS_CNT))
#define BLKE ((int*)(WSP + WS_BLKE))
#define XH ((bf16*)(WSP + WS_XH))
#define X1H ((bf16*)(WSP + WS_X1H))
#define LOGITS ((float*)(WSP + WS_LOGITS))
#define HS8 ((unsigned char*)(WSP + WS_HS))
#define XA ((float*)(WSP + WS_XA))
#define PREB ((bf16*)(WSP + WS_PRE))
#define X1 ((float*)(WSP + WS_X1))
#define H8 ((unsigned char*)(WSP + WS_H))
#define XH8 ((unsigned char*)(WSP + WS_X1))
#define X1F8 ((unsigned char*)(WSP + WS_XA))
#define PROJ ((bf16*)(WSP + WS_PROJ))
#define YA ((bf16*)(WSP + WS_YA))
#define YB ((bf16*)(WSP + WS_YB))
#define MIXB ((bf16*)(WSP + WS_MIX))
#define MIX8 ((unsigned char*)(WSP + WS_MIX + 64 * MiB))
#define YY ((unsigned char*)(WSP + WS_Y))
#define YS ((bf16*)(WSP + WS_PRE))
#define WGU8 ((unsigned char*)(WSP + WS_WEXP))
#define WD8 ((unsigned char*)(WSP + WS_WEXP + 128 * MiB))
#define CTLW ((unsigned*)(WSP + WS_CTL))
#define WSM(off) ((bf16*)(WSP + WS_WSMALL + (size_t)layer * WSMALL_LAYER + (off)))
#define WIN8 ((unsigned char*)WSM(WSM_WIN))
#define WPA_T WSM(WSM_WPA)
#define WPB_T WSM(WSM_WPB)
#define WOUT_T WSM(WSM_WOUT)
#define WRS_T WSM(WSM_WRS)
#define WDS_T WSM(WSM_WDS)
#define XIN (layer == 0 ? args.in[I_X] : (const float*)XA)
#define XOUT (layer == DEPTH - 1 ? args.out : XA)
#define W_IN (args.in[I_WIN] + (size_t)layer * D * IN_COLS)

template <int layer>
__device__ __forceinline__ void layer_body(const Args& args, LAS unsigned char* lds, const XcdBarrier& bar, int G, int bid, int NGW, int wave0) {
    const int lo = args.ph_lo, hi = args.ph_hi;
    LAS int* blke_lds = (LAS int*)(lds + BLKE_LDS_OFF);
    {
        const int pb = layer * NPH;


        if (layer == 0 && IN(pb + PH_CVT)) for (int rep_ = 0; rep_ < REP_CVT; ++rep_) { PHASE_WS;
            LAS float* wz = (LAS float*)lds;
            for (int i = tid; i < D * 2; i += NTHR) { const int k = i >> 1, hh = (i & 1) * 4; *(LAS f32x4*)(wz + k * 8 + hh) = *(const f32x4*)(W_IN + (size_t)k * IN_COLS + OC_ZF + hh); }
            __syncthreads();
            {
                LAS float* scr = (LAS float*)(lds + 32768 + wave * 8448);
                int base = 0;
                const int nsmall = layer == 0 ? 12 * DEPTH : 0;
#pragma unroll 1
                for (int jj = 0; jj < nsmall; ++jj) {
                    const float* W; int ldw, K, col0, ncols, row0; bf16* WT;
                    {
                        const int l2 = jj / 12, j = jj % 12;
                        unsigned char* w2 = (unsigned char*)(WSP + WS_WSMALL + (size_t)l2 * WSMALL_LAYER);
                        const float* wg = args.in[I_WGS] + (size_t)l2 * D * DS; const float* wu = args.in[I_WUS] + (size_t)l2 * D * DS;
                        W = args.in[I_WIN] + (size_t)l2 * D * IN_COLS; ldw = IN_COLS; K = D; col0 = 0; ncols = OC_ZF; WT = (bf16*)(w2 + WSM_WIN); row0 = 0;
                        if (j == 1) { col0 = OC_GA; ncols = 2048; row0 = PC_GA; }
                        else if (j == 2) { W = args.in[I_WPA] + (size_t)l2 * 512 * D; ldw = D; K = 512; ncols = D; WT = (bf16*)(w2 + WSM_WPA); }
                        else if (j == 3) { W = args.in[I_WPB] + (size_t)l2 * 512 * D; ldw = D; K = 512; ncols = D; WT = (bf16*)(w2 + WSM_WPB); }
                        else if (j == 4) { W = args.in[I_WOUT] + (size_t)l2 * D * D; ldw = D; ncols = D; WT = (bf16*)(w2 + WSM_WOUT); }
                        else if (j >= 5 && j <= 8) { W = (j & 1) ? wg : wu; ldw = DS; col0 = j >= 7 ? 128 : 0; ncols = 128; WT = (bf16*)(w2 + WSM_WRS); row0 = (j - 5) * 128; }
                        else if (j == 9) { W = args.in[I_WR] + (size_t)l2 * D * NE; ldw = NE; ncols = NE; WT = (bf16*)(w2 + WSM_WRS); row0 = 512; }
                        else if (j == 10) { W = args.in[I_WDS] + (size_t)l2 * DS * D; ldw = D; K = DS; ncols = D; WT = (bf16*)(w2 + WSM_WDS); }
                        else if (j == 11) { ncols = 0; }
                    }
                    const bool j8 = (jj % 12) != 9;
                    const int nnb = ncols / 32, nit = (K / 64) * nnb;
                    const int first = ((gw - base) % NGW + NGW) % NGW;
                    for (int it = first; it < nit; it += NGW) { const int kb = it / nnb, nb = it % nnb; if (j8) cvt_item_f8(W, ldw, col0 + nb * 32, kb * 64, (unsigned char*)WT, K, row0 + nb * 32, scr, lane); else cvt_item(W, ldw, col0 + nb * 32, kb * 64, WT, K, row0 + nb * 32, scr, lane); }
                    base += nit;
                }
            }
            const float* bfg = args.in[I_BF] + layer * FH;
            for (int t = gw; t < T; t += NGW) {
                float z[8];
#pragma unroll
                for (int hh = 0; hh < 8; ++hh) z[hh] = 0.f;
#pragma unroll 1
                for (int j = 0; j < 4; ++j) {
                    f32x4 v;
                    if (layer == 0) { v = *(const f32x4*)(args.in[I_X] + (size_t)t * D + lane * 4 + 256 * j);
                        *(u32x2*)(XH + (size_t)t * D + lane * 4 + 256 * j) = (u32x2){pk2(v.x, v.y), pk2(v.z, v.w)};
                        *(unsigned*)(XH8 + (size_t)t * D + lane * 4 + 256 * j) = pg8::pk4_fp8_(v); }
                    else { const u32x2 xb = *(const u32x2*)(XH + (size_t)t * D + lane * 4 + 256 * j);
                        v = (f32x4){bf2f(xb.x & 0xffffu), bf2f(xb.x >> 16), bf2f(xb.y & 0xffffu), bf2f(xb.y >> 16)}; }
                    const float vv[4] = {v.x, v.y, v.z, v.w};
#pragma unroll
                    for (int e = 0; e < 4; ++e) { const int k = lane * 4 + 256 * j + e; const f32x4 w0 = *(const LAS f32x4*)(wz + k * 8), w1 = *(const LAS f32x4*)(wz + k * 8 + 4);
                        z[0] += vv[e] * w0.x; z[1] += vv[e] * w0.y; z[2] += vv[e] * w0.z; z[3] += vv[e] * w0.w; z[4] += vv[e] * w1.x; z[5] += vv[e] * w1.y; z[6] += vv[e] * w1.z; z[7] += vv[e] * w1.w; }
                }
#pragma unroll
                for (int hh = 0; hh < 8; ++hh) z[hh] = wave_sum(z[hh]);
                if (lane < 8) { float zz = z[0];
#pragma unroll
                    for (int hh = 1; hh < 8; ++hh) zz = (lane == hh) ? z[hh] : zz;
                    const float v = zz + bfg[lane];
                    LOGF[(size_t)t * 8 + lane] = fminf(v, 0.f) - log1pf(__expf(-fabsf(v))); KN2[(size_t)t * 8 + lane] = 0.f; }
            }
            __syncthreads();
        }
        if (layer == 0) SEAM(pb + PH_CVT);

        if (IN(pb + PH_INPROJ)) for (int rep_ = 0; rep_ < REP_INPROJ; ++rep_) { PHASE_WS;
            {
            LAS float* sb = (LAS float*)lds;
            for (int u = bid; u < BATCH * FH; u += G) {
                const int b = u >> 3, h = u & 7;
                float v[16], s = 0.f;
#pragma unroll
                for (int i = 0; i < 16; ++i) { v[i] = LOGF[((size_t)b * SEQ + tid * 16 + i) * 8 + h]; s += v[i]; v[i] = s; }
                __syncthreads();
                sb[tid] = s; __syncthreads();
                int cur = 0;
                for (int off = 1; off < NTHR; off <<= 1) { float x = sb[cur * 512 + tid]; if (tid >= off) x += sb[cur * 512 + tid - off]; sb[(cur ^ 1) * 512 + tid] = x; cur ^= 1; __syncthreads(); }
                const float excl = sb[cur * 512 + tid] - s;
#pragma unroll
                for (int i = 0; i < 16; ++i) { CC[((size_t)b * SEQ + tid * 16 + i) * 8 + h] = v[i] + excl; CKB[(size_t)u * SEQ + tid * 16 + i] = -(v[i] + excl) * LOG2E; }
            }
            __syncthreads();
            }
            pg8::DenseT<true> P; P.init((const bf16*)XH8, D / 2, (const bf16*)WIN8, D / 2, T, PC, D / 2, G, bid); P.sa = 0x7F7F7F7F; P.sb = 0x79797979;
            pg8::FEpiInProj E{PROJ, KN2};
            pg8::gemm_phase<pg8::FEpiInProj, pg8::DenseT<true>, true, true>(lds + RING_OFF, P, E, tid);
        }
        SEAM(pb + PH_INPROJ);

        for (int arep = 0; arep < REP_ATTN; ++arep) {
        if (IN(pb + PH_ATTN)) { PHASE_WS;
#define FOX_FROM_QUEUE() do { LAS int* qslot = (LAS int*)(lds + attn_body::SKIP_LDS + 48); \
                const attn_body::AttnTensors AT{args.ws, (long)(WS_PROJ + PC_BQ * 2), (long)(WS_PROJ + PC_BK * 2), (long)(WS_PROJ + PC_BV * 2), (long)WS_CKB, (long)WS_KN2, (long)WS_YB}; \
                const attn_body::QueueOrder S{CTLW + CW_AQ + 64 * layer + 16 * arep, qslot, tid}; \
                attn_body::attn_phase<attn_body::QueueOrder>(tid, (char*)lds, AT, S); } while (0)
            if (G == 256 && bid < NATT) FOX_FROM_QUEUE();
        }
        if (IN(pb + PH_ATTN)) { PHASE_WS;
            if (G == 256) {
                for (int rep_ = 0; rep_ < REP_CONV; ++rep_) {
                unsigned* cqh = CTLW + CW_CQ + 64 * layer + 16 * rep_ + 32 * arep;
                    LAS float* scr = (LAS float*)(lds + wave * 8448);
                const float* WGE = args.in[I_WGE] + (size_t)layer * NE * D * DE; const float* WUE = args.in[I_WUE] + (size_t)layer * NE * D * DE; const float* WDE = args.in[I_WDE] + (size_t)layer * NE * DE * D;
                constexpr int NIT_E = 3 * 32768;
#define CVT_DECODE(g_, src_, ldw_, dst_, ldd_) do { const int part_ = (g_) >> 15, r_ = (g_) & 32767, e_ = r_ >> 7, it_ = r_ & 127; \
                    if (part_ < 2) { const int kb_ = it_ >> 3, nb_ = it_ & 7; src_ = (part_ ? WUE : WGE) + (size_t)e_ * D * DE + (size_t)(kb_ * 64) * DE + nb_ * 32; ldw_ = DE; \
                        dst_ = WGU8 + (size_t)e_ * 512 * D + (size_t)((nb_ >> 2) * 256 + part_ * 128 + (nb_ & 3) * 32) * D + kb_ * 64; ldd_ = D; } \
                    else { const int kb_ = it_ >> 5, nb_ = it_ & 31; src_ = WDE + (size_t)e_ * DE * D + (size_t)(kb_ * 64) * D + nb_ * 32; ldw_ = D; \
                        dst_ = WD8 + (size_t)e_ * D * DE + (size_t)(nb_ * 32) * DE + kb_ * 64; ldd_ = DE; } } while (0)
                    constexpr int NCHK = NIT_E / 8;
                    f32x4 b0[8], b1[8], b2[8], b3[8]; const float* sp = nullptr; int lw = 0; unsigned char *d0 = nullptr, *d1 = nullptr, *d2 = nullptr, *d3 = nullptr; int l0 = 0, l1 = 0, l2 = 0, l3 = 0;
#define CVT_LD(buf, dd, ll, g_) do { CVT_DECODE((g_), sp, lw, dd, ll); cvt_load4(buf, sp, lw, lane); } while (0)
#define CVT_ST(buf, dd, ll) cvt_store4_f8(buf, dd, ll, scr, lane)
                    for (;;) {
                        int c = 0; if (lane == 0) c = (int)__hip_atomic_fetch_add(cqh, 1u, __ATOMIC_RELAXED, __HIP_MEMORY_SCOPE_AGENT);
                        c = __builtin_amdgcn_readfirstlane(c); if (c >= NCHK) break;
                        const int g = c * 8;
                        CVT_LD(b0, d0, l0, g); CVT_LD(b1, d1, l1, g + 1); CVT_LD(b2, d2, l2, g + 2);
                        CVT_LD(b3, d3, l3, g + 3); CVT_ST(b0, d0, l0);
                        CVT_LD(b0, d0, l0, g + 4); CVT_ST(b1, d1, l1);
                        CVT_LD(b1, d1, l1, g + 5); CVT_ST(b2, d2, l2);
                        CVT_LD(b2, d2, l2, g + 6); CVT_ST(b3, d3, l3);
                        CVT_LD(b3, d3, l3, g + 7); CVT_ST(b0, d0, l0);
                        CVT_ST(b1, d1, l1); CVT_ST(b2, d2, l2); CVT_ST(b3, d3, l3);
                    }
#undef CVT_LD
#undef CVT_ST
#undef CVT_DECODE
                }
                __syncthreads();
            }
        }
        if (IN(pb + PH_ATTN)) { PHASE_WS;
            if (G == 256 && bid >= NATT) FOX_FROM_QUEUE();
#undef FOX_FROM_QUEUE
        }
        if (IN(pb + PH_ATTN)) { PHASE_WS;
            const float* sinks = args.in[I_SINK] + layer * AQH; const float* relb = args.in[I_RELB];
            attn_body::swa_tables(tid, relb, T5_BUCKET, (char*)lds); __syncthreads();
            for (int rep_ = 0; rep_ < REP_SWA; ++rep_)
            for (int u = bid; u < BATCH * AKVH * (SEQ / 64); u += G) {
                const int qt = u & 127, bk = u >> 7;
                attn_body::swa_unit(tid, bk >> 1, bk & 1, qt, PROJ + PC_AQ, PROJ + PC_AK, PROJ + PC_AV, sinks, YA, (char*)lds);
            }
            __syncthreads();
        }
        }
        SEAM(pb + PH_ATTN);

        if (IN(pb + PH_PROJ)) for (int rep_ = 0; rep_ < REP_PROJA; ++rep_) { PHASE_WS;
            {   pg8::DenseT<true> P; P.init(YA, 256, WPA_T, 256, T, D, 256, G, bid); P.sa = 0x7B7B7B7B; P.sb = 0x79797979;
                pg8::FEpiMix<false> E{MIXB, MIX8, PROJ, PC_GA};
                pg8::gemm_phase<pg8::FEpiMix<false>, pg8::DenseT<true>, true, true>(lds + RING_OFF, P, E, tid); }
            {
                pg8::DenseT<true> P; P.init(YB, 256, WPB_T, 256, T, D, 256, G, bid); P.sa = 0x7B7B7B7B; P.sb = 0x79797979;
                pg8::FEpiMix<true> E{MIXB, MIX8, PROJ, PC_GB};
                pg8::gemm_phase<pg8::FEpiMix<true>, pg8::DenseT<true>, true, true>(lds + RING_OFF, P, E, tid); }
        }
        SEAM(pb + PH_PROJ);

        if (IN(pb + PH_OUT)) for (int rep_ = 0; rep_ < REP_OUT; ++rep_) { PHASE_WS;
            pg8::DenseT<true> P; P.init((const bf16*)MIX8, D / 2, WOUT_T, D / 2, T, D, D / 2, G, bid); P.sa = 0x7B7B7B7B; P.sb = 0x79797979;
            pg8::FEpiResB<layer == 0> E{PREB, layer == 0 ? (const void*)args.in[I_X] : (const void*)XH};
            pg8::gemm_phase<pg8::FEpiResB<layer == 0>, pg8::DenseT<true>, true, true>(lds + RING_OFF, P, E, tid);
        }
        SEAM(pb + PH_OUT);

        if (IN(pb + PH_LN1)) for (int rep_ = 0; rep_ < REP_LN1; ++rep_) { PHASE_WS;
            const float* gg = args.in[I_LN1G] + layer * D; const float* bb = args.in[I_LN1B] + layer * D;
            for (int t = gw; t < T; t += NGW) {
                f32x4 v[4];
#pragma unroll
                for (int j = 0; j < 4; ++j) { const u32x2 pb_ = *(const u32x2*)(PREB + (size_t)t * D + lane * 4 + 256 * j);
                    v[j] = (f32x4){bf2f(pb_.x & 0xffffu), bf2f(pb_.x >> 16), bf2f(pb_.y & 0xffffu), bf2f(pb_.y >> 16)}; }
                ln_row(v, gg, bb, lane);
#pragma unroll
                for (int j = 0; j < 4; ++j) { *(u32x2*)(X1H + (size_t)t * D + lane * 4 + 256 * j) = (u32x2){pk2(v[j].x, v[j].y), pk2(v[j].z, v[j].w)};
                    *(unsigned*)(X1F8 + (size_t)t * D + lane * 4 + 256 * j) = pg8::pk4_fp8_(v[j]); }
            }
        }
        SEAM(pb + PH_LN1);

        if (IN(pb + PH_RS)) for (int rep_ = 0; rep_ < REP_RS; ++rep_) { PHASE_WS;
            if (bid < 128) {
                pg8::Dense P; P.init(X1H, D, WRS_T + (size_t)512 * D, D, T, NE, D, 128, bid);
                pg8::FEpiRouter E{LOGITS};
                pg8::gemm_phase<pg8::FEpiRouter, pg8::Dense, true, true>(lds + RING_OFF, P, E, tid);
            } else {
                pg8::DenseT<true> P; P.init((const bf16*)X1F8, D / 2, WRS_T, D / 2, T, 512, D / 2, 128, bid - 128); P.sa = 0x7F7F7F7F; P.sb = 0x79797979;
                pg8::FEpiShared8 E{HS8};
                pg8::gemm_phase<pg8::FEpiShared8, pg8::DenseT<true>, true, true>(lds + RING_OFF, P, E, tid);
            }
        }
        SEAM(pb + PH_RS);

        if (IN(pb + PH_ROUTE)) for (int rep_ = 0; rep_ < REP_ROUTE; ++rep_) { PHASE_WS;
            LAS int* hist = (LAS int*)lds;
            const f32x4 rb = *(const f32x4*)(args.in[I_RB] + layer * NE + lane * 4);
            for (int c = bid; c < NCHUNK; c += G) {
                __syncthreads();
                if (tid < NE) hist[tid] = 0;
                __syncthreads();
                for (int i = 0; i < CHUNK / NWAVES; ++i) route_token(c * CHUNK + wave * (CHUNK / NWAVES) + i, LOGITS, rb, TOPE, TOPW, hist, lane);
                __syncthreads();
                if (tid < NE) CNT[c * NE + tid] = hist[tid];
            }
            __syncthreads();
        }
        SEAM(pb + PH_ROUTE);

        if (IN(pb + PH_OFFS)) for (int rep_ = 0; rep_ < REP_OFFS; ++rep_) { PHASE_WS;
            LAS int* sb = (LAS int*)lds;
            LAS int* base = sb + 512;
            LAS int* cursor = base + 256;
            for (int c = bid; c < NCHUNK; c += G) {
                __syncthreads();
                int tot = 0, below = 0, padded = 0;
                { const int e2 = tid & (NE - 1), half = tid >> 8;
#pragma unroll 16
                  for (int c2 = half * (NCHUNK / 2); c2 < (half + 1) * (NCHUNK / 2); ++c2) { const int v = CNT[c2 * NE + e2]; tot += v; below += (c2 < c) ? v : 0; }
                  if (half) { base[e2] = tot; cursor[e2] = below; }
                  __syncthreads();
                  if (!half) { tot += base[e2]; below += cursor[e2]; } }
                __syncthreads();
                if (tid < NE) { padded = (tot + EB - 1) / EB * EB; sb[tid] = padded; cursor[tid] = 0; }
                __syncthreads();
                int cur = 0;
                for (int off = 1; off < NE; off <<= 1) { if (tid < NE) { int x = sb[cur * 256 + tid]; if (tid >= off) x += sb[cur * 256 + tid - off]; sb[(cur ^ 1) * 256 + tid] = x; } cur ^= 1; __syncthreads(); }
                if (tid < NE) {
                    const int pend = sb[cur * 256 + tid], pstart = pend - padded;
                    base[tid] = pstart + below;
                    if (tid == c) {
                        for (int r = pstart + tot; r < pend; ++r) { ROWTOK[r] = 0; ROWW[r] = 0.f; }
                        for (int rb = pstart / EB; rb < pend / EB; ++rb) BLKE[rb] = c;
                    }
                    if (tid == NE - 1 && c == NE - 1) CTLW[CW_NB] = (unsigned)(pend / EB);
                }
                __syncthreads();
                for (int a = tid; a < CHUNK * TOPK; a += NTHR) {
                    const size_t ai = (size_t)c * CHUNK * TOPK + a; const int e = TOPE[ai];
                    const int pos = base[e] + __hip_atomic_fetch_add(cursor + e, 1, __ATOMIC_RELAXED, __HIP_MEMORY_SCOPE_WORKGROUP);
                    ROWTOK[pos] = (int)(ai >> 3); ROWW[pos] = TOPW[ai]; INV[ai] = pos;
                }
            }
            __syncthreads();
        }
        SEAM(pb + PH_OFFS);

        if (IN(pb + PH_GU)) for (int rep_ = 0; rep_ < REP_GU; ++rep_) { PHASE_WS;
            const int nb = (int)__hip_atomic_load(CTLW + CW_NB, __ATOMIC_RELAXED, __HIP_MEMORY_SCOPE_AGENT);
            for (int i = tid; i < NRB; i += NTHR) blke_lds[i] = i < nb ? BLKE[i] : 0;
            __syncthreads();
            pg8::Grouped<true, 2, true> P; P.A = (const bf16*)X1F8; P.Bt = (const bf16*)WGU8; P.K = D / 2; P.lda = D / 2; P.ldb = D / 2; P.rowidx = ROWTOK; P.blke = blke_lds; P.bstride = (size_t)512 * D / 2; P.nwg = nb * 2; P.G = G; P.c = bid;
            P.sa = 0x7F7F7F7F; P.sb = 0x79797979;
            pg8::FEpiGU8 E{H8, ROWW};
            pg8::gemm_phase<pg8::FEpiGU8, pg8::Grouped<true, 2, true>, true, true>(lds + RING_OFF, P, E, tid);
        }
        SEAM(pb + PH_GU);

        if (IN(pb + PH_DOWN)) for (int rep_ = 0; rep_ < REP_DOWN; ++rep_) { PHASE_WS;
            const int nb = (int)__hip_atomic_load(CTLW + CW_NB, __ATOMIC_RELAXED, __HIP_MEMORY_SCOPE_AGENT);
            for (int i = tid; i < NRB; i += NTHR) blke_lds[i] = i < nb ? BLKE[i] : 0;
            __syncthreads();
            { pg8::Grouped<false, 4, true> P; P.A = (const bf16*)H8; P.Bt = (const bf16*)WD8; P.K = DE / 2; P.lda = DE / 2; P.ldb = DE / 2; P.rowidx = nullptr; P.blke = blke_lds; P.bstride = (size_t)D * DE / 2; P.nwg = nb * 4; P.G = G; P.c = bid;
              P.sa = 0x7A7A7A7A; P.sb = 0x7D7D7D7D;
              pg8::FEpiDown E{YY};
              pg8::gemm_phase<pg8::FEpiDown, pg8::Grouped<false, 4, true>, true, false>(lds + RING_OFF, P, E, tid); }
        }
        if (IN(pb + PH_DOWN)) for (int rep_ = 0; rep_ < REP_DOWN; ++rep_) { PHASE_WS;
            { pg8::DenseT<true> P; P.init((const bf16*)HS8, DS / 2, WDS_T, DS / 2, T, D, DS / 2, G, bid); P.sa = 0x7C7C7C7C; P.sb = 0x79797979;
              pg8::FEpiPlain E{YS};
              pg8::gemm_phase<pg8::FEpiPlain, pg8::DenseT<true>, true, true>(lds + RING_OFF, P, E, tid); }
        }
        SEAM(pb + PH_DOWN);

        if (IN(pb + PH_LN2)) for (int rep_ = 0; rep_ < REP_LN2; ++rep_) { PHASE_WS;
            const float* gg = args.in[I_LN2G] + layer * D; const float* bb = args.in[I_LN2B] + layer * D;
            LAS float* wz = (LAS float*)lds;
            if (layer < DEPTH - 1) { const float* wn = args.in[I_WIN] + (size_t)(layer + 1) * D * IN_COLS;
                for (int i = tid; i < D * 2; i += NTHR) { const int k = i >> 1, hh = (i & 1) * 4; *(LAS f32x4*)(wz + k * 8 + hh) = *(const f32x4*)(wn + (size_t)k * IN_COLS + OC_ZF + hh); }
                __syncthreads(); }
            int ic[2], in_[2];
#pragma unroll
            for (int q = 0; q < 2; ++q) { const int tq = gw + q * NGW; ic[q] = (tq < T && lane < TOPK) ? INV[(size_t)tq * TOPK + lane] : 0; }
            for (int t = gw; t < T; t += 2 * NGW) {
                u32x2 ysr[2][4], xbr[2][4]; int y8[2][TOPK][4];
#pragma unroll
                for (int q = 0; q < 2; ++q) { const int tq = t + q * NGW; if (tq < T) {
#pragma unroll
                    for (int j = 0; j < 4; ++j) { ysr[q][j] = *(const u32x2*)(YS + (size_t)tq * D + lane * 4 + 256 * j); xbr[q][j] = *(const u32x2*)(X1H + (size_t)tq * D + lane * 4 + 256 * j); }
#pragma unroll
                    for (int k = 0; k < TOPK; ++k) { const int r = __builtin_amdgcn_readlane(ic[q], k);
#pragma unroll
                        for (int j = 0; j < 4; ++j) y8[q][k][j] = *(const int*)(YY + (size_t)r * D + lane * 4 + 256 * j); } } }
#pragma unroll
                for (int q = 0; q < 2; ++q) { const int tn = t + (2 + q) * NGW; in_[q] = (tn < T && lane < TOPK) ? INV[(size_t)tn * TOPK + lane] : 0; }
#pragma unroll
                for (int q = 0; q < 2; ++q) { const int tq = t + q * NGW; if (tq < T) {
                f32x4 v[4], racc[4];
#pragma unroll
                for (int j = 0; j < 4; ++j) { const u32x2 y = ysr[q][j], xb = xbr[q][j]; racc[j] = (f32x4){0.f, 0.f, 0.f, 0.f};
                    v[j] = (f32x4){bf2f(xb.x & 0xffffu), bf2f(xb.x >> 16), bf2f(xb.y & 0xffffu), bf2f(xb.y >> 16)} * ALPHA + (f32x4){bf2f(y.x & 0xffffu), bf2f(y.x >> 16), bf2f(y.y & 0xffffu), bf2f(y.y >> 16)}; }
#pragma unroll
                for (int k = 0; k < TOPK; ++k)
#pragma unroll
                    for (int j = 0; j < 4; ++j) { const int y = y8[q][k][j];
                        const f32x2 lo = __builtin_amdgcn_cvt_pk_f32_fp8(y, false), hi = __builtin_amdgcn_cvt_pk_f32_fp8(y, true);
                        racc[j] = racc[j] + (f32x4){lo.x, lo.y, hi.x, hi.y}; }
#pragma unroll
                for (int j = 0; j < 4; ++j) v[j] = v[j] + racc[j] * (1.0f / pg8::Y8_SCALE);
                ln_row(v, gg, bb, lane);
#pragma unroll
                for (int j = 0; j < 4; ++j) {
                    if (layer == DEPTH - 1) *(f32x4*)(args.out + (size_t)tq * D + lane * 4 + 256 * j) = v[j];
                    else { *(u32x2*)(XH + (size_t)tq * D + lane * 4 + 256 * j) = (u32x2){pk2(v[j].x, v[j].y), pk2(v[j].z, v[j].w)};
                        *(unsigned*)(XH8 + (size_t)tq * D + lane * 4 + 256 * j) = pg8::pk4_fp8_(v[j]); } }
                if (layer < DEPTH - 1) {
                    float z[8];
#pragma unroll
                    for (int hh = 0; hh < 8; ++hh) z[hh] = 0.f;
#pragma unroll 1
                    for (int j = 0; j < 4; ++j) { const float vv[4] = {v[j].x, v[j].y, v[j].z, v[j].w};
#pragma unroll
                        for (int e = 0; e < 4; ++e) { const int k = lane * 4 + 256 * j + e; const f32x4 w0 = *(const LAS f32x4*)(wz + k * 8), w1 = *(const LAS f32x4*)(wz + k * 8 + 4);
                            z[0] += vv[e] * w0.x; z[1] += vv[e] * w0.y; z[2] += vv[e] * w0.z; z[3] += vv[e] * w0.w; z[4] += vv[e] * w1.x; z[5] += vv[e] * w1.y; z[6] += vv[e] * w1.z; z[7] += vv[e] * w1.w; } }
#pragma unroll
                    for (int hh = 0; hh < 8; ++hh) z[hh] = wave_sum(z[hh]);
                    if (lane < 8) { float zz = z[0];
#pragma unroll
                        for (int hh = 1; hh < 8; ++hh) zz = (lane == hh) ? z[hh] : zz;
                        const float qv = zz + args.in[I_BF][(layer + 1) * FH + lane];
                        LOGF[(size_t)tq * 8 + lane] = fminf(qv, 0.f) - log1pf(__expf(-fabsf(qv))); KN2[(size_t)tq * 8 + lane] = 0.f; }
                }
                } }
                ic[0] = in_[0]; ic[1] = in_[1];
            }
        }
        SEAM(pb + PH_LN2);
    }
}

__global__ void __launch_bounds__(NTHR, 2) fwd_kernel(Args args) {
    extern __shared__ __attribute__((aligned(16))) unsigned char lds_raw[];
    LAS unsigned char* lds = (LAS unsigned char*)lds_raw;
    volatile LAS unsigned* MISC = (volatile LAS unsigned*)(lds + MISC_OFF);
    const int G = gridDim.x, bid = blockIdx.x, NGW = G * NWAVES;
    const int wave0 = __builtin_amdgcn_readfirstlane(threadIdx.x >> 6);
    unsigned char* ws = args.ws;
    unsigned* ctl = (unsigned*)(ws + WS_CTL);
    for (int u = threadIdx.x; u < (LDS_BYTES - LDSCTL_OFF) / 4; u += NTHR) ((LAS unsigned*)(lds + LDSCTL_OFF))[u] = 0u;
    __syncthreads();
    XcdBarrier bar = xcd_barrier_post(ctl + CW_BAR, MISC + 8, (unsigned)wave0);

    layer_body<0>(args, lds, bar, G, bid, NGW, wave0);
    layer_body<1>(args, lds, bar, G, bid, NGW, wave0);
}
#undef IN
#undef SEAM


#ifndef MK_PER_PHASE
#define MK_PER_PHASE 0
#endif
extern "C" void kernel_launch(void* const* d_in, const int* in_sizes, int n_in, void* d_out, int out_size, void* d_ws, size_t ws_size, hipStream_t stream) {
    static int grid = 0;
    if (grid == 0) {
        if (n_in != 20 || in_sizes[0] != T * D || out_size != T * D || ws_size < WS_END) { fprintf(stderr, "kernel_launch: unexpected shapes/workspace (n_in %d, ws %zu)\n", n_in, ws_size); grid = -1; return; }
        int dev = 0, cus = 0, per_cu = 0;
        if (hipGetDevice(&dev) != hipSuccess || hipDeviceGetAttribute(&cus, hipDeviceAttributeMultiprocessorCount, dev) != hipSuccess) { grid = -1; return; }
        if (hipFuncSetAttribute((const void*)fwd_kernel, hipFuncAttributeMaxDynamicSharedMemorySize, LDS_BYTES) != hipSuccess) { fprintf(stderr, "kernel_launch: hipFuncSetAttribute failed\n"); grid = -1; return; }
        if (hipOccupancyMaxActiveBlocksPerMultiprocessor(&per_cu, (const void*)fwd_kernel, NTHR, LDS_BYTES) != hipSuccess || per_cu < 1) fprintf(stderr, "kernel_launch: occupancy query reports %d\n", per_cu);
        (void)hipGetLastError();
        grid = cus;
    }
    if (grid < 0) return;
    (void)hipMemsetAsync((char*)d_ws + WS_CTL, 0, CTL_ZERO_BYTES, stream);
    Args a{};
    for (int i = 0; i < 20; ++i) a.in[i] = (const float*)d_in[i];
    a.out = (float*)d_out; a.ws = (unsigned char*)d_ws;
    constexpr int NTOT = DEPTH * NPH;
#if MK_PER_PHASE
    for (int p = 0; p < NTOT; ++p) { a.ph_lo = p; a.ph_hi = p + 1; hipLaunchKernelGGL(fwd_kernel, dim3(grid), dim3(NTHR), LDS_BYTES, stream, a); }
#else
    a.ph_lo = 0; a.ph_hi = NTOT; hipLaunchKernelGGL(fwd_kernel, dim3(grid), dim3(NTHR), LDS_BYTES, stream, a);
#endif
}
```

```cpp
#include <hip/hip_runtime.h>
#include <cstdio>
#include <cstdint>

constexpr int BATCH = 4, SEQ = 8192, D = 1024, T = BATCH * SEQ, DEPTH = 2;
constexpr int HD = 64, AQH = 8, AKVH = 2, WIN = 128, FH = 8;
constexpr int NE = 256, TOPK = 8, NG = 8, TOPG = 4, DE = 256, DS = 256, EB = 256;
constexpr int IN_COLS = 4360, PC = 4352;
constexpr int OC_AQ = 0, OC_AK = 512, OC_AV = 640, OC_BQ = 768, OC_BK = 1280, OC_BV = 1792, OC_ZF = 2304, OC_GA = 2312, OC_GB = 3336;
constexpr int PC_AQ = 0, PC_AK = 512, PC_AV = 640, PC_BQ = 768, PC_BK = 1280, PC_BV = 1792, PC_GA = 2304, PC_GB = 3328;
constexpr int NASSIGN = T * TOPK;
constexpr int PROWS = (NASSIGN + NE * (EB - 1) + EB - 1) / EB * EB;
constexpr int NRB = PROWS / EB;
constexpr float LN_EPS = 1e-5f;
constexpr float ALPHA = 1.41421356237309515f;
constexpr float ROUTED_SCALE = 2.5f;
constexpr float LOG2E = 1.4426950408889634f;
constexpr float C2 = 0.125f * 1.4426950408889634f;
constexpr int CHUNK = 128, NCHUNK = T / CHUNK;

constexpr size_t MiB = 1u << 20;
constexpr size_t WS_CTL = 0, CTL_ZERO_BYTES = 1 * MiB;
constexpr size_t WS_WSMALL = 2 * MiB;
constexpr size_t WS_LOGF = 40 * MiB, WS_C = 41 * MiB, WS_TOPE = 42 * MiB, WS_TOPW = 43 * MiB, WS_INV = 44 * MiB;
constexpr size_t WS_ROWTOK = 45 * MiB, WS_ROWW = 47 * MiB, WS_CNT = 49 * MiB, WS_BLKE = 50 * MiB, WS_CKB = 51 * MiB, WS_KN2 = 52 * MiB;
constexpr size_t WS_XH = 64 * MiB, WS_X1H = 128 * MiB, WS_LOGITS = 192 * MiB, WS_HS = 224 * MiB;
constexpr size_t WS_XA = 256 * MiB, WS_PRE = 384 * MiB, WS_X1 = 512 * MiB, WS_H = 640 * MiB;
constexpr size_t WS_R1 = 800 * MiB;
constexpr size_t WS_PROJ = WS_R1, WS_YA = WS_R1 + 272 * MiB, WS_YB = WS_R1 + 304 * MiB, WS_MIX = WS_R1 + 336 * MiB, WS_Y = WS_R1;
constexpr size_t WS_WEXP = 1440 * MiB, WS_END = 1824 * MiB;
static_assert((size_t)T * PC * 2 <= 272 * MiB && (size_t)PROWS * D * 1 <= 640 * MiB && (size_t)PROWS * DE * 2 <= 160 * MiB, "ws map");
constexpr int CW_BAR = 4096;
constexpr int CW_NB = 64;
constexpr int CW_AQ = 128, CW_CQ = 256;

constexpr int RING_OFF = 0, RING_BYTES = 131072;
constexpr int LDSCTL_OFF = RING_BYTES, MISC_OFF = LDSCTL_OFF + 320;
constexpr int LDS_BYTES = 147456;
constexpr int NWAVES = 8, NTHR = 512;

#define GAS __attribute__((address_space(1)))
typedef unsigned short bf16;
typedef float f32x4 __attribute__((ext_vector_type(4)));
typedef float f32x2 __attribute__((ext_vector_type(2)));
typedef unsigned u32x4 __attribute__((ext_vector_type(4)));
typedef unsigned u32x2 __attribute__((ext_vector_type(2)));
typedef short bf16x8 __attribute__((ext_vector_type(8)));

__device__ __forceinline__ float bf2f(unsigned v) { return __uint_as_float(v << 16); }
__device__ __forceinline__ unsigned f2bf(float f) { unsigned u = __float_as_uint(f); return (u + 0x7fffu + ((u >> 16) & 1u)) >> 16; }
__device__ __forceinline__ unsigned pk2(float lo, float hi) { unsigned r; asm("v_cvt_pk_bf16_f32 %0, %1, %2" : "=v"(r) : "v"(lo), "v"(hi)); return r; }
__device__ __forceinline__ float sat8(float v) { return __builtin_amdgcn_fmed3f(v, -448.0f, 448.0f); }
__device__ __forceinline__ int cvt2_fp8(float a, float b, int old, bool hi) { return hi ? __builtin_amdgcn_cvt_pk_fp8_f32(sat8(a), sat8(b), old, true) : __builtin_amdgcn_cvt_pk_fp8_f32(sat8(a), sat8(b), old, false); }
__device__ __forceinline__ float sigmoidf_(float v) { return __builtin_amdgcn_rcpf(1.0f + __expf(-v)); }
__device__ __forceinline__ float siluf_(float v) { return v * __builtin_amdgcn_rcpf(1.0f + __expf(-v)); }
__device__ __forceinline__ int lane_id_opaque() { int l; asm volatile("v_mbcnt_lo_u32_b32 %0, -1, 0\n\tv_mbcnt_hi_u32_b32 %0, -1, %0" : "=v"(l)); return l; }
__device__ __forceinline__ float rdlane_f(float v, int l) { return __int_as_float(__builtin_amdgcn_readlane(__float_as_int(v), l)); }
template <int CTRL> __device__ __forceinline__ float dpp_f(float v) { return __int_as_float(__builtin_amdgcn_update_dpp(0, __float_as_int(v), CTRL, 0xf, 0xf, true)); }
__device__ __forceinline__ float wave_max_all(float v) {
    v = fmaxf(v, dpp_f<0xB1>(v)); v = fmaxf(v, dpp_f<0x4E>(v)); v = fmaxf(v, dpp_f<0x141>(v)); v = fmaxf(v, dpp_f<0x140>(v));
    const float r0 = rdlane_f(v, 0), r1 = rdlane_f(v, 16), r2 = rdlane_f(v, 32), r3 = rdlane_f(v, 48);
    return fmaxf(fmaxf(r0, r1), fmaxf(r2, r3));
}
__device__ __forceinline__ float wave_sum(float v) {
    v += dpp_f<0xB1>(v); v += dpp_f<0x4E>(v); v += dpp_f<0x141>(v); v += dpp_f<0x140>(v);
    return (rdlane_f(v, 0) + rdlane_f(v, 16)) + (rdlane_f(v, 32) + rdlane_f(v, 48));
}
__device__ const unsigned char T5_BUCKET[128] = {0, 1, 2, 3, 4, 5, 6, 7, 8, 9, 10, 11, 12, 13, 14, 15, 16, 16, 16, 17, 17, 18, 18, 18, 19, 19, 19, 20, 20, 20, 20, 21, 21, 21, 21, 22, 22, 22, 22, 22, 23, 23, 23, 23, 23, 23, 24, 24, 24, 24, 24, 24, 25, 25, 25, 25, 25, 25, 25, 26, 26, 26, 26, 26, 26, 26, 26, 27, 27, 27, 27, 27, 27, 27, 27, 27, 27, 28, 28, 28, 28, 28, 28, 28, 28, 28, 28, 29, 29, 29, 29, 29, 29, 29, 29, 29, 29, 29, 29, 30, 30, 30, 30, 30, 30, 30, 30, 30, 30, 30, 30, 30, 30, 31, 31, 31, 31, 31, 31, 31, 31, 31, 31, 31, 31, 31, 31, 31};

constexpr size_t WSMALL_LAYER = 15 * MiB, WSM_WIN = 0, WSM_WPA = 8 * MiB + 512 * 1024, WSM_WPB = WSM_WPA + MiB, WSM_WOUT = WSM_WPB + MiB, WSM_WRS = WSM_WOUT + 2 * MiB, WSM_WDS = WSM_WRS + MiB + 512 * 1024;
static_assert((size_t)PC * D * 2 <= WSM_WPA && WSM_WDS + 512 * 1024 <= WSMALL_LAYER && WS_WSMALL + 2 * WSMALL_LAYER <= WS_LOGF, "small weights map");
constexpr int BLKE_LDS_OFF = RING_BYTES + 1024;
static_assert(BLKE_LDS_OFF + NRB * 4 <= LDS_BYTES, "LDS map");

constexpr int NATT = 160;
#define XB_TMO      128
#define XB_XCNT(j)  (256  + 64 * (j))
#define XB_XSUB(j)  (1280 + 64 * (j))
#define XB_XGEN(j)  (2304 + 64 * (j))
#define XB_TOP      3328
#define XB_TOPGEN   3392
#define XCD_BAR_WORDS 3456
#define XB_SPIN_CAP (1u << 18)
#define LAS __attribute__((address_space(3)))

__device__ __forceinline__ unsigned xb_ld(unsigned* p)              { return __hip_atomic_load(p, __ATOMIC_RELAXED, __HIP_MEMORY_SCOPE_AGENT); }
__device__ __forceinline__ unsigned xb_add(unsigned* p, unsigned v) { return __hip_atomic_fetch_add(p, v, __ATOMIC_RELAXED, __HIP_MEMORY_SCOPE_AGENT); }
__device__ __forceinline__ unsigned xb_xcc_id() { return (unsigned)__builtin_amdgcn_s_getreg((3 << 11) | 20) & 0xFu; }
#define XB_SPIN(cond, bar) do { unsigned _sp = 0; while (cond) { __builtin_amdgcn_s_sleep(1); \
    if ((++_sp & 255u) == 0u) { if (xb_ld(&(bar)[XB_TMO])) break; if (_sp > XB_SPIN_CAP) { atomicAdd(&(bar)[XB_TMO], 1u); break; } } } } while (0)

struct XcdBarrier {
    unsigned* bar; unsigned x;
    volatile LAS unsigned* st;
    unsigned wv;
};
#define XB_THREAD0(b) ((b).wv == 0u && lane_id_opaque() == 0)

__device__ __forceinline__ XcdBarrier xcd_barrier_post(unsigned* bar, volatile LAS unsigned* st, unsigned wv) {
    XcdBarrier b; b.bar = bar; b.x = xb_xcc_id(); b.st = st; b.wv = wv;
    if (XB_THREAD0(b)) (void)xb_add(&bar[XB_XCNT(b.x)], 1u);
    return b;
}
__device__ __forceinline__ void xcd_barrier_complete(unsigned* bar, unsigned x, unsigned& nloc, unsigned& nx) {
    const unsigned G = gridDim.x * gridDim.y * gridDim.z;
    unsigned sum, cnt, mine, sp = 0u;
    for (;;) {
        sum = 0u; cnt = 0u; mine = 0u;
#pragma unroll
        for (unsigned j = 0; j < 16; ++j) { const unsigned c = xb_ld(&bar[XB_XCNT(j)]); sum += c; cnt += (c > 0u) ? 1u : 0u; mine = (j == x) ? c : mine; }
        if (sum == G) break;
        __builtin_amdgcn_s_sleep(1);
        if ((++sp & 255u) == 0u) { if (xb_ld(&bar[XB_TMO])) break; if (sp > XB_SPIN_CAP) { atomicAdd(&bar[XB_TMO], 1u); break; } }
    }
    nloc = mine > 0u ? mine : 1u; nx = cnt > 0u ? cnt : 1u;
}

__device__ __forceinline__ void xcd_barrier(const XcdBarrier& b) {
    asm volatile("s_waitcnt vmcnt(0)" ::: "memory");
    __syncthreads();
    if (XB_THREAD0(b)) {
        unsigned* bar = b.bar;
        __builtin_amdgcn_s_waitcnt(0);
        unsigned nloc = b.st[0], nx = b.st[1];
        if (nloc == 0u) { xcd_barrier_complete(bar, b.x, nloc, nx); b.st[0] = nloc; b.st[1] = nx; }
        const unsigned old = xb_add(&bar[XB_XSUB(b.x)], 1u);
        const unsigned gen = old / nloc;
        if (old + 1u == (gen + 1u) * nloc) {
            __builtin_amdgcn_fence(__ATOMIC_RELEASE, "agent");
            asm volatile("s_waitcnt vmcnt(0)" ::: "memory");
            const unsigned og = xb_add(&bar[XB_TOP], 1u);
            const unsigned tg = og / nx;
            if (og + 1u == (tg + 1u) * nx) xb_add(&bar[XB_TOPGEN], 1u);
            else XB_SPIN(xb_ld(&bar[XB_TOPGEN]) == tg, bar);
            __builtin_amdgcn_fence(__ATOMIC_ACQUIRE, "agent");
            xb_add(&bar[XB_XGEN(b.x)], 1u);
            asm volatile("s_waitcnt vmcnt(0)" ::: "memory");
        } else {
            XB_SPIN(xb_ld(&bar[XB_XGEN(b.x)]) == gen, bar);
            __builtin_amdgcn_fence(__ATOMIC_ACQUIRE, "agent");
            asm volatile("s_waitcnt vmcnt(0)" ::: "memory");
        }
    }
    __syncthreads();
}


namespace pg8 {
typedef unsigned short bf16_t;
constexpr int BM = 256, BK = 64, HALF = 128, HTB = HALF * BK * 2  , STAGE_BYTES = 8 * HTB, NXCD = 8, WGM = 8;

__host__ __device__ __forceinline__ int lds_byte(int r, int c) { const int st = (r >> 4) * 2 + (c >> 5), rr = r & 15, cc = c & 31, ob = rr * 64 + cc * 2; return st * 1024 + (ob ^ (((ob >> 9) & 1) << 5)); }
__host__ __device__ __forceinline__ void stage_rc(int b, int& R, int& C) { const int st = b / 1024, sb = b % 1024, swz = sb ^ (((sb >> 9) & 1) << 5); R = (st >> 1) * 16 + swz / 64; C = (st & 1) * 32 + (swz % 64) / 2; }
__host__ __device__ __forceinline__ int perm32(int rho) { const int n = rho >> 4, i = rho & 15; return 8 * (i >> 2) + 4 * n + (i & 3); }

struct Unit { int pm, pn, e; };

__device__ __forceinline__ bool xcd_linear(int i, int G, int c, int nwg, int& wgid) {
    const long L = (long)i * G + c; if (L >= nwg) return false;
    wgid = (int)L; { const int q = nwg / NXCD, r = nwg % NXCD, xcd = wgid % NXCD, off = wgid / NXCD; wgid = (xcd < r ? xcd * (q + 1) : r * (q + 1) + (xcd - r) * q) + off; }
    return true;
}
template <bool FP8_> struct DenseT {
    static constexpr bool GATHER = false, FP8 = FP8_; int sa, sb;
    const bf16_t* A; const bf16_t* Bt; int K, lda, ldb; const int* rowidx;
    int nM, nN, nwg, G, c;
    __device__ __forceinline__ void init(const bf16_t* A_, int lda_, const bf16_t* Bt_, int ldb_, int M, int N, int K_, int G_, int c_) { A = A_; Bt = Bt_; K = K_; lda = lda_; ldb = ldb_; rowidx = nullptr; nM = M / BM; nN = N / BM; nwg = nM * nN; G = G_; c = c_; }
    __device__ __forceinline__ bool next(int i, Unit& u) const {
        int wgid; if (!xcd_linear(i, G, c, nwg, wgid)) return false;
        const int nig = WGM * nN, gid = wgid / nig, fm = gid * WGM, gsz = (nM - fm) < WGM ? (nM - fm) : WGM;
        u.pm = fm + ((wgid % nig) % gsz); u.pn = (wgid % nig) / gsz; u.e = 0; return true;
    }
    __device__ __forceinline__ const char* a_base(const Unit& u) const { return (const char*)A + (size_t)u.pm * BM * lda * 2; }
    __device__ __forceinline__ const char* b_base(const Unit& u) const { return (const char*)Bt + (size_t)u.pn * BM * ldb * 2; }
};
typedef DenseT<false> Dense;
template <bool GATHER_, int NPN, bool FP8_ = false>
struct Grouped {
    static constexpr bool GATHER = GATHER_, FP8 = FP8_; int sa, sb;
    const bf16_t* A; const bf16_t* Bt; int K, lda, ldb; const int* rowidx; const LAS int* blke; size_t bstride;
    int nwg, G, c;
    __device__ __forceinline__ bool next(int i, Unit& u) const {
        if constexpr (NPN == 4) {
            int w2; if (!xcd_linear(i >> 1, G, c, nwg >> 1, w2)) return false;
            u.pm = w2 >> 1; u.pn = ((w2 & 1) << 1) | (i & 1); u.e = blke[u.pm]; return true;
        } else {
            int wgid; if (!xcd_linear(i, G, c, nwg, wgid)) return false;
            u.pm = wgid / NPN; u.pn = wgid % NPN; u.e = blke[u.pm]; return true;
        }
    }
    __device__ __forceinline__ const char* a_base(const Unit& u) const { return GATHER_ ? (const char*)A : (const char*)A + (size_t)u.pm * BM * lda * 2; }
    __device__ __forceinline__ const char* b_base(const Unit& u) const { return (const char*)(Bt + (size_t)u.e * bstride) + (size_t)u.pn * BM * ldb * 2; }
};

__device__ __forceinline__ unsigned cvt_pk_bf16(float lo, float hi) { unsigned r; asm volatile("v_cvt_pk_bf16_f32 %0, %1, %2" : "=v"(r) : "v"(lo), "v"(hi)); return r; }

template <class Epi, class Prob, bool ALIGN_EPI, bool SP2>
__device__ __forceinline__ void gemm_phase(LAS unsigned char* lds, const Prob& P, const Epi& E, int tid_in) {
    constexpr bool GA = Prob::GATHER, F8 = Prob::FP8;
    typedef int v8i32 __attribute__((ext_vector_type(8))); typedef int v4i32 __attribute__((ext_vector_type(4)));
    int sc_a = 0, sc_b = 0; if constexpr (F8) { sc_a = P.sa; sc_b = P.sb; }
    int tid_ = tid_in; asm volatile("" : "+v"(tid_));
    const int tid = tid_, wid = __builtin_amdgcn_readfirstlane(tid >> 6), lane = tid & 63, wr = wid >> 2, wc = wid & 3, fr = lane & 15, fq = lane >> 4;
    int K_ = P.K; asm volatile("" : "+s"(K_));
    const int K = K_, nt = K / BK;
    unsigned voffB[2], vAc[2][2], vAn[2][2]; int RA[2]; unsigned CA2[2];
    const unsigned ldab = (unsigned)P.lda * 2u;
#pragma unroll
    for (int i = 0; i < 2; ++i) { int R, C; stage_rc(tid * 16 + i * 8192, R, C); const int Rb = Epi::PERM ? ((R & ~31) + perm32(R & 31)) : R;
        voffB[i] = (unsigned)(Rb * P.ldb + C) * 2u; RA[i] = R; CA2[i] = (unsigned)C * 2u;
        vAc[0][i] = (unsigned)R * ldab + CA2[i]; vAc[1][i] = vAc[0][i] + (unsigned)HALF * ldab; vAn[0][i] = vAc[0][i]; vAn[1][i] = vAc[1][i]; }
    const size_t kstep = (size_t)(BK * 2);
    const size_t hstepB = (size_t)HALF * P.ldb * 2;
    const unsigned ldsw = (unsigned)wid * 1024u;
    const int aoff = lds_byte(wr * 64 + fr, fq * 8), boff = lds_byte(wc * 32 + fr, fq * 8);
#define PG8_SA(b, h) (((b) * 2 + (h)) * HTB)
#define PG8_SB(b, h) ((4 + (b) * 2 + (h)) * HTB)
#define PG8_STAGE(bufoff, gbase, voff) do { _Pragma("unroll") for (int _i = 0; _i < 2; ++_i) \
        __builtin_amdgcn_global_load_lds((const unsigned*)((const char*)(gbase) + (voff)[_i]), (LAS unsigned*)(lds + (bufoff) + ldsw + _i * 8192), 16, 0, 0); } while (0)
#define PG8_LDA(dst, b, h) do { if constexpr (F8) { _Pragma("unroll") for (int m = 0; m < 4; ++m) dst##8[m] = __builtin_shufflevector(*(const LAS v4i32*)(lds + PG8_SA(b, h) + aoff + m * 2048), *(const LAS v4i32*)(lds + PG8_SA(b, h) + aoff + m * 2048 + 1024), 0, 1, 2, 3, 4, 5, 6, 7); } \
    else { _Pragma("unroll") for (int m = 0; m < 4; ++m) _Pragma("unroll") for (int k = 0; k < 2; ++k) dst[m][k] = *(const LAS bf16x8*)(lds + PG8_SA(b, h) + aoff + m * 2048 + k * 1024); } } while (0)
#define PG8_LDB(dst, b, h) do { if constexpr (F8) { _Pragma("unroll") for (int n = 0; n < 2; ++n) dst##8[n] = __builtin_shufflevector(*(const LAS v4i32*)(lds + PG8_SB(b, h) + boff + n * 2048), *(const LAS v4i32*)(lds + PG8_SB(b, h) + boff + n * 2048 + 1024), 0, 1, 2, 3, 4, 5, 6, 7); } \
    else { _Pragma("unroll") for (int n = 0; n < 2; ++n) _Pragma("unroll") for (int k = 0; k < 2; ++k) dst[n][k] = *(const LAS bf16x8*)(lds + PG8_SB(b, h) + boff + n * 2048 + k * 1024); } } while (0)
#define PG8_MMA16(ai, bj, At, Bt) do { __builtin_amdgcn_s_setprio(1); _Pragma("unroll") for (int m = 0; m < 4; ++m) _Pragma("unroll") for (int n = 0; n < 2; ++n) _Pragma("unroll") for (int k = 0; k < 2; ++k) \
        acc[ai][bj][m][n] = __builtin_amdgcn_mfma_f32_16x16x32_bf16(Bt[n][k], At[m][k], acc[ai][bj][m][n], 0, 0, 0); __builtin_amdgcn_s_setprio(0); } while (0)
#define PG8_MMA(ai, bj, At, Bt) do { if constexpr (F8) PG8_MMA8(ai, bj, At, Bt); else PG8_MMA16(ai, bj, At, Bt); } while (0)
#define PG8_MMA8(ai, bj, At, Bt) do { __builtin_amdgcn_s_setprio(1); _Pragma("unroll") for (int m = 0; m < 4; ++m) _Pragma("unroll") for (int n = 0; n < 2; ++n) \
        asm volatile("v_mfma_scale_f32_16x16x128_f8f6f4 %0, %1, %2, %0, %3, %4 op_sel_hi:[0,0,0]" : "+v"(acc[ai][bj][m][n]) : "v"(Bt##8[n]), "v"(At##8[m]), "v"(sc_b), "v"(sc_a)); \
        __builtin_amdgcn_s_setprio(0); } while (0)
#define PG8_WAIT_V(n) asm volatile("s_waitcnt vmcnt(" #n ")" ::: "memory")
#define PG8_WAIT_L(n) asm volatile("s_waitcnt lgkmcnt(" #n ")" ::: "memory")
#define PG8_BAR __builtin_amdgcn_s_barrier()
#define PG8_SCHED __builtin_amdgcn_sched_barrier(0)
#define PG8_TOKOFF(dst, u) do { _Pragma("unroll") for (int _h = 0; _h < 2; ++_h) _Pragma("unroll") for (int _i = 0; _i < 2; ++_i) \
        dst[_h][_i] = (unsigned)P.rowidx[(u).pm * BM + _h * HALF + RA[_i]] * ldab + CA2[_i]; } while (0)
    Unit cur, nxt, nn; int ui = 0;
    if (!P.next(0, cur)) return;
    bool has_next = P.next(1, nxt);
    if constexpr (GA) { PG8_TOKOFF(vAc, cur); if (has_next) PG8_TOKOFF(vAn, nxt); else { vAn[0][0] = vAc[0][0]; vAn[0][1] = vAc[0][1]; vAn[1][0] = vAc[1][0]; vAn[1][1] = vAc[1][1]; } }
    f32x4 acc[2][2][4][2];
#pragma unroll
    for (int a = 0; a < 2; ++a)
#pragma unroll
        for (int b = 0; b < 2; ++b)
#pragma unroll
            for (int m = 0; m < 4; ++m)
#pragma unroll
                for (int n = 0; n < 2; ++n) acc[a][b][m][n] = (f32x4){0.f, 0.f, 0.f, 0.f};
    bf16x8 At[4][2], B0[2][2], B1[2][2]; v8i32 At8[4], B08[2], B18[2];
    const char* cA = P.a_base(cur); const char* cB = P.b_base(cur);
    if constexpr (SP2) {
        PG8_STAGE(PG8_SB(0, 0), cB, voffB); PG8_STAGE(PG8_SB(0, 1), cB + hstepB, voffB); PG8_STAGE(PG8_SA(0, 0), cA, vAc[0]); PG8_STAGE(PG8_SA(0, 1), cA, vAc[1]);
        if (wr == 1) PG8_BAR;
        PG8_WAIT_V(2); PG8_BAR;
        PG8_STAGE(PG8_SB(1, 0), cB + kstep, voffB); PG8_STAGE(PG8_SA(1, 0), cA + kstep, vAc[0]); PG8_STAGE(PG8_SB(1, 1), cB + hstepB + kstep, voffB);
        PG8_WAIT_V(6); PG8_BAR;
    } else {
        PG8_STAGE(PG8_SB(0, 0), cB, voffB); PG8_STAGE(PG8_SA(0, 0), cA, vAc[0]); PG8_STAGE(PG8_SB(0, 1), cB + hstepB, voffB); PG8_STAGE(PG8_SA(0, 1), cA, vAc[1]);
        if (wr == 1) PG8_BAR;
        PG8_WAIT_V(4); PG8_BAR;
        PG8_STAGE(PG8_SB(1, 0), cB + kstep, voffB); PG8_STAGE(PG8_SA(1, 0), cA + kstep, vAc[0]); PG8_STAGE(PG8_SB(1, 1), cB + hstepB + kstep, voffB);
        PG8_WAIT_V(6); PG8_BAR;
    }
    for (;;) {
        const bool has_nn = has_next && P.next(ui + 2, nn);
        const char* nA = has_next ? P.a_base(nxt) : cA; const char* nB = has_next ? P.b_base(nxt) : cB;
        for (int t = 0; t < nt; t += 2) {
            const bool last = (t == nt - 2);
            const char* a1 = cA + (size_t)(t + 1) * kstep;
            const char* a2 = last ? nA : cA + (size_t)(t + 2) * kstep; const char* b2 = last ? nB : cB + (size_t)(t + 2) * kstep;
            const char* a3 = a2 + kstep; const char* b3 = b2 + kstep;
            unsigned w0[2], w1[2];
#pragma unroll
            for (int i = 0; i < 2; ++i) { w0[i] = (GA && last) ? vAn[0][i] : vAc[0][i]; w1[i] = (GA && last) ? vAn[1][i] : vAc[1][i]; }
            if constexpr (SP2) {
            PG8_LDB(B0, 0, 0); PG8_LDB(B1, 0, 1); PG8_SCHED; PG8_LDA(At, 0, 0); PG8_STAGE(PG8_SA(1, 1), a1, vAc[1]);
            PG8_WAIT_V(8); PG8_WAIT_L(0); PG8_BAR; PG8_MMA(0, 0, At, B0); PG8_MMA(0, 1, At, B1); PG8_BAR; PG8_SCHED;
            PG8_LDA(At, 0, 1); PG8_STAGE(PG8_SB(0, 0), b2, voffB); PG8_STAGE(PG8_SB(0, 1), b2 + hstepB, voffB); PG8_STAGE(PG8_SA(0, 0), a2, w0);
            PG8_WAIT_V(8); PG8_WAIT_L(0); PG8_BAR; PG8_MMA(1, 0, At, B0); PG8_MMA(1, 1, At, B1); PG8_BAR; PG8_SCHED;
            PG8_LDB(B0, 1, 0); PG8_LDB(B1, 1, 1); PG8_SCHED; PG8_LDA(At, 1, 0); PG8_STAGE(PG8_SA(0, 1), a2, w1);
            PG8_WAIT_V(8); PG8_WAIT_L(0); PG8_BAR; PG8_MMA(0, 0, At, B0); PG8_MMA(0, 1, At, B1); PG8_BAR; PG8_SCHED;
            PG8_LDA(At, 1, 1); PG8_STAGE(PG8_SB(1, 0), b3, voffB); PG8_STAGE(PG8_SB(1, 1), b3 + hstepB, voffB); PG8_STAGE(PG8_SA(1, 0), a3, w0);
            PG8_WAIT_V(8); PG8_WAIT_L(0); PG8_BAR; PG8_MMA(1, 0, At, B0); PG8_MMA(1, 1, At, B1); PG8_BAR; PG8_SCHED;
            } else {
            PG8_LDB(B0, 0, 0); PG8_SCHED; PG8_LDA(At, 0, 0); PG8_STAGE(PG8_SA(1, 1), a1, vAc[1]);
            PG8_WAIT_L(8); PG8_BAR; PG8_WAIT_L(0); PG8_MMA(0, 0, At, B0); PG8_BAR; PG8_SCHED;
            PG8_LDB(B1, 0, 1); PG8_STAGE(PG8_SB(0, 0), b2, voffB);
            PG8_BAR; PG8_WAIT_L(0); PG8_MMA(0, 1, At, B1); PG8_BAR;
            PG8_LDA(At, 0, 1); PG8_STAGE(PG8_SA(0, 0), a2, w0);
            PG8_BAR; PG8_WAIT_L(0); PG8_MMA(1, 0, At, B0); PG8_BAR; PG8_SCHED;
            PG8_STAGE(PG8_SB(0, 1), b2 + hstepB, voffB);
            PG8_WAIT_V(6); PG8_BAR; PG8_MMA(1, 1, At, B1); PG8_BAR;
            PG8_LDB(B0, 1, 0); PG8_SCHED; PG8_LDA(At, 1, 0); PG8_STAGE(PG8_SA(0, 1), a2, w1);
            PG8_WAIT_L(8); PG8_BAR; PG8_WAIT_L(0); PG8_MMA(0, 0, At, B0); PG8_BAR; PG8_SCHED;
            PG8_LDB(B1, 1, 1); PG8_STAGE(PG8_SB(1, 0), b3, voffB);
            PG8_BAR; PG8_WAIT_L(0); PG8_MMA(0, 1, At, B1); PG8_BAR;
            PG8_LDA(At, 1, 1); PG8_STAGE(PG8_SA(1, 0), a3, w0);
            PG8_BAR; PG8_WAIT_L(0); PG8_MMA(1, 0, At, B0); PG8_BAR; PG8_SCHED;
            PG8_STAGE(PG8_SB(1, 1), b3 + hstepB, voffB);
            PG8_WAIT_V(6); PG8_BAR; PG8_MMA(1, 1, At, B1); PG8_BAR;
            }
        }
        if constexpr (ALIGN_EPI) { if (wr == 0) PG8_BAR; }
        if constexpr (F8) asm volatile("s_nop 15\n\ts_nop 15" ::: "memory");
        int tk[2][2] = {{0, 0}, {0, 0}};
        if constexpr (GA) { if (has_nn) {
#pragma unroll
            for (int h = 0; h < 2; ++h)
#pragma unroll
                for (int i = 0; i < 2; ++i) tk[h][i] = P.rowidx[nn.pm * BM + h * HALF + RA[i]]; }
            asm volatile("" ::: "memory"); }
        E(acc, cur, wr, wc, fr, fq);
        if (!has_next) break;
        if constexpr (GA) {
#pragma unroll
            for (int h = 0; h < 2; ++h)
#pragma unroll
                for (int i = 0; i < 2; ++i) { vAc[h][i] = vAn[h][i]; vAn[h][i] = has_nn ? (unsigned)tk[h][i] * ldab + CA2[i] : vAn[h][i]; } }
#pragma unroll
        for (int a = 0; a < 2; ++a)
#pragma unroll
            for (int b = 0; b < 2; ++b)
#pragma unroll
                for (int m = 0; m < 4; ++m)
#pragma unroll
                    for (int n = 0; n < 2; ++n) acc[a][b][m][n] = (f32x4){0.f, 0.f, 0.f, 0.f};
        cur = nxt; cA = nA; cB = nB; nxt = nn; has_next = has_nn; ++ui;
        if constexpr (ALIGN_EPI) { if (wr == 1) PG8_BAR; }
    }
    PG8_WAIT_V(0);
    if constexpr (!ALIGN_EPI) { if (wr == 0) PG8_BAR; }
    PG8_BAR;
#undef PG8_SA
#undef PG8_SB
#undef PG8_STAGE
#undef PG8_LDA
#undef PG8_LDB
#undef PG8_MMA
#undef PG8_MMA8
#undef PG8_MMA16
#undef PG8_WAIT_V
#undef PG8_WAIT_L
#undef PG8_BAR
#undef PG8_SCHED
#undef PG8_TOKOFF
}

typedef const f32x4 (&AccRef)[2][2][4][2];
__device__ __forceinline__ u32x4 pack8(f32x4 v0, f32x4 v1) { u32x4 w; w.x = cvt_pk_bf16(v0[0], v0[1]); w.y = cvt_pk_bf16(v0[2], v0[3]); w.z = cvt_pk_bf16(v1[0], v1[1]); w.w = cvt_pk_bf16(v1[2], v1[3]); return w; }
__device__ __forceinline__ unsigned pk4_fp8_(f32x4 v) { int w = 0; w = cvt2_fp8(v[0], v[1], w, false); w = cvt2_fp8(v[2], v[3], w, true); return (unsigned)w; }
__device__ __forceinline__ u32x4 widen16(u32x2 a, u32x2 b) {
    const auto r0 = __builtin_amdgcn_permlane16_swap(a.x, b.x, false, false), r1 = __builtin_amdgcn_permlane16_swap(a.y, b.y, false, false);
    return (u32x4){r0[0], r1[0], r0[1], r1[1]};
}
__device__ __forceinline__ f32x4 sig4(f32x4 v) { return (f32x4){sigmoidf_(v[0]), sigmoidf_(v[1]), sigmoidf_(v[2]), sigmoidf_(v[3])}; }
__device__ __forceinline__ f32x4 swiglu4(f32x4 g, f32x4 u) { return (f32x4){siluf_(g[0]) * u[0], siluf_(g[1]) * u[1], siluf_(g[2]) * u[2], siluf_(g[3]) * u[3]}; }
__device__ __forceinline__ void unpack8(u32x4 w, f32x4& a, f32x4& b) { a = (f32x4){bf2f(w.x & 0xffffu), bf2f(w.x >> 16), bf2f(w.y & 0xffffu), bf2f(w.y >> 16)}; b = (f32x4){bf2f(w.z & 0xffffu), bf2f(w.z >> 16), bf2f(w.w & 0xffffu), bf2f(w.w >> 16)}; }

struct FEpiInProj { static constexpr bool PERM = true; bf16_t* Pj; float* KN2;
    __device__ __forceinline__ void operator()(AccRef acc, const Unit& u, int wr, int wc, int fr, int fq) const {
        const int mode = (u.pn == 0 || u.pn == 1 || u.pn == 3 || u.pn == 4) ? 1 : (u.pn >= 9 ? 2 : 0);
        const int row0 = u.pm * BM + wr * 64 + fr, col0 = u.pn * BM + wc * 32 + 8 * fq;
#pragma unroll
        for (int ai = 0; ai < 2; ++ai)
#pragma unroll
            for (int m = 0; m < 4; ++m) { bf16_t* rowp = Pj + (size_t)(row0 + ai * HALF + m * 16) * PC + col0;
#pragma unroll
                for (int bj = 0; bj < 2; ++bj) { f32x4 v0 = acc[ai][bj][m][0], v1 = acc[ai][bj][m][1];
                    if (mode == 1) { v0 = v0 * C2; v1 = v1 * C2; } else if (mode == 2) { v0 = sig4(v0); v1 = sig4(v1); }
                    const u32x4 w = pack8(v0, v1);
                    *(u32x4*)(rowp + bj * HALF) = w;
                    if (u.pn == 5 || u.pn == 6) {
                        f32x4 r0, r1; unpack8(w, r0, r1);
                        float ss = (r0[0] * r0[0] + r0[1] * r0[1]) + (r0[2] * r0[2] + r0[3] * r0[3]) + (r1[0] * r1[0] + r1[1] * r1[1]) + (r1[2] * r1[2] + r1[3] * r1[3]);
                        ss += __shfl_xor(ss, 16); ss += __shfl_xor(ss, 32);
                        if (fq == 0) atomicAdd(KN2 + (size_t)(row0 + ai * HALF + m * 16) * 8 + (u.pn - 5) * 4 + bj * 2 + (wc >> 1), ss); } } }
    } };
constexpr float MIX8_SCALE = 16.0f;
#define EPI_GLD16(dst, ptr) asm volatile("global_load_dwordx4 %0, %1, off" : "=v"(dst) : "v"(ptr) : "memory")
template <bool LAST> struct FEpiMix { static constexpr bool PERM = true; bf16_t* TMP; unsigned char* M8; const bf16_t* Pj; int gcol;
    __device__ __forceinline__ void operator()(AccRef acc, const Unit& u, int wr, int wc, int fr, int fq) const {
        const int row0 = u.pm * BM + wr * 64 + fr, col0 = u.pn * BM + wc * 32 + 8 * fq;
        u32x4 gv[2][2][2], tv[2][2][2];
#define MIX_LD(buf, k_) do { _Pragma("unroll") for (int mi = 0; mi < 2; ++mi) _Pragma("unroll") for (int bj = 0; bj < 2; ++bj) { \
            const size_t row_ = (size_t)(row0 + ((k_) >> 1) * HALF + (2 * ((k_) & 1) + mi) * 16); const int col_ = col0 + bj * HALF; \
            EPI_GLD16(gv[buf][mi][bj], Pj + row_ * PC + gcol + col_); if (LAST) EPI_GLD16(tv[buf][mi][bj], TMP + row_ * D + col_); } } while (0)
        MIX_LD(0, 0);
#pragma unroll
        for (int k = 0; k < 4; ++k) {
            const int cb = k & 1;
            if (k < 3) { if (cb == 0) MIX_LD(1, k + 1); else MIX_LD(0, k + 1); }
            if (k < 3) { if (LAST) asm volatile("s_waitcnt vmcnt(8)" ::: "memory"); else asm volatile("s_waitcnt vmcnt(4)" ::: "memory"); } else asm volatile("s_waitcnt vmcnt(0)" ::: "memory");
            u32x2 pk[2][2];
#pragma unroll
            for (int mi = 0; mi < 2; ++mi)
#pragma unroll
                for (int bj = 0; bj < 2; ++bj) { asm volatile("" : "+v"(gv[cb][mi][bj])); if (LAST) asm volatile("" : "+v"(tv[cb][mi][bj]));
                    const int ai = k >> 1, m = 2 * (k & 1) + mi; const size_t row = (size_t)(row0 + ai * HALF + m * 16); const int col = col0 + bj * HALF;
                    f32x4 g0, g1; unpack8(gv[cb][mi][bj], g0, g1);
                    f32x4 v0 = acc[ai][bj][m][0] * g0, v1 = acc[ai][bj][m][1] * g1;
                    if (LAST) { f32x4 m0, m1; unpack8(tv[cb][mi][bj], m0, m1); v0 = (v0 + m0) * MIX8_SCALE; v1 = (v1 + m1) * MIX8_SCALE;
                        pk[mi][bj] = (u32x2){pk4_fp8_(v0), pk4_fp8_(v1)}; }
                    else *(u32x4*)(TMP + row * D + col) = pack8(v0, v1); }
            if (LAST) {
#pragma unroll
                for (int bj = 0; bj < 2; ++bj) { const int ai = k >> 1; const size_t row = (size_t)(row0 + ai * HALF + (2 * (k & 1) + (fq & 1)) * 16);
                    *(u32x4*)(M8 + row * D + u.pn * BM + bj * HALF + wc * 32 + 16 * (fq >> 1)) = widen16(pk[0][bj], pk[1][bj]); } }
        }
#undef MIX_LD
    } };
struct FEpiRes { static constexpr bool PERM = false; float* O; const float* R;
    __device__ __forceinline__ void operator()(AccRef acc, const Unit& u, int wr, int wc, int fr, int fq) const {
        const int row0 = u.pm * BM + wr * 64 + fr, col0 = u.pn * BM + wc * 32 + 4 * fq;
#pragma unroll
        for (int ai = 0; ai < 2; ++ai)
#pragma unroll
            for (int m = 0; m < 4; ++m) { const size_t off = (size_t)(row0 + ai * HALF + m * 16) * D + col0;
#pragma unroll
                for (int bj = 0; bj < 2; ++bj)
#pragma unroll
                    for (int n = 0; n < 2; ++n) { const f32x4 r = *(const f32x4*)(R + off + bj * HALF + n * 16); *(f32x4*)(O + off + bj * HALF + n * 16) = r * ALPHA + acc[ai][bj][m][n]; } }
    } };
struct FEpiRS { static constexpr bool PERM = true; bf16_t* HSb; float* LG;
    __device__ __forceinline__ void operator()(AccRef acc, const Unit& u, int wr, int wc, int fr, int fq) const {
        const int row0 = u.pm * BM + wr * 64 + fr, c8 = wc * 32 + 8 * fq;
        if (u.pn < 2) {
#pragma unroll
            for (int ai = 0; ai < 2; ++ai)
#pragma unroll
                for (int m = 0; m < 4; ++m) { const size_t row = (size_t)(row0 + ai * HALF + m * 16);
                    *(u32x4*)(HSb + row * DS + u.pn * HALF + c8) = pack8(swiglu4(acc[ai][0][m][0], acc[ai][1][m][0]), swiglu4(acc[ai][0][m][1], acc[ai][1][m][1])); }
        } else {
#pragma unroll
            for (int ai = 0; ai < 2; ++ai)
#pragma unroll
                for (int m = 0; m < 4; ++m) { float* rp = LG + (size_t)(row0 + ai * HALF + m * 16) * NE + c8;
#pragma unroll
                    for (int bj = 0; bj < 2; ++bj)
#pragma unroll
                        for (int n = 0; n < 2; ++n) *(f32x4*)(rp + bj * HALF + 4 * n) = acc[ai][bj][m][n]; }
        }
    } };
struct FEpiRouter { static constexpr bool PERM = true; float* LG;
    __device__ __forceinline__ void operator()(AccRef acc, const Unit& u, int wr, int wc, int fr, int fq) const {
        const int row0 = u.pm * BM + wr * 64 + fr, c8 = wc * 32 + 8 * fq;
#pragma unroll
        for (int ai = 0; ai < 2; ++ai)
#pragma unroll
            for (int m = 0; m < 4; ++m) { float* rp = LG + (size_t)(row0 + ai * HALF + m * 16) * NE + c8;
#pragma unroll
                for (int bj = 0; bj < 2; ++bj)
#pragma unroll
                    for (int n = 0; n < 2; ++n) *(f32x4*)(rp + bj * HALF + 4 * n) = acc[ai][bj][m][n]; }
    } };
constexpr float HS8_SCALE = 8.0f;
struct FEpiShared8 { static constexpr bool PERM = true; unsigned char* Hb;
    __device__ __forceinline__ void operator()(AccRef acc, const Unit& u, int wr, int wc, int fr, int fq) const {
        const int row0 = u.pm * BM + wr * 64 + fr + (fq & 1) * 16, cb = u.pn * HALF + wc * 32 + 16 * (fq >> 1);
#pragma unroll
        for (int ai = 0; ai < 2; ++ai)
#pragma unroll
            for (int mp = 0; mp < 2; ++mp) { const size_t row = (size_t)(row0 + ai * HALF + mp * 32);
                *(u32x4*)(Hb + row * DS + cb) = widen16(
                    (u32x2){pk4_fp8_(swiglu4(acc[ai][0][2 * mp][0], acc[ai][1][2 * mp][0]) * HS8_SCALE), pk4_fp8_(swiglu4(acc[ai][0][2 * mp][1], acc[ai][1][2 * mp][1]) * HS8_SCALE)},
                    (u32x2){pk4_fp8_(swiglu4(acc[ai][0][2 * mp + 1][0], acc[ai][1][2 * mp + 1][0]) * HS8_SCALE), pk4_fp8_(swiglu4(acc[ai][0][2 * mp + 1][1], acc[ai][1][2 * mp + 1][1]) * HS8_SCALE)}); }
    } };
struct FEpiGU { static constexpr bool PERM = true; bf16_t* Hb;
    __device__ __forceinline__ void operator()(AccRef acc, const Unit& u, int wr, int wc, int fr, int fq) const {
        const int row0 = u.pm * BM + wr * 64 + fr, c8 = wc * 32 + 8 * fq;
#pragma unroll
        for (int ai = 0; ai < 2; ++ai)
#pragma unroll
            for (int m = 0; m < 4; ++m) { const size_t row = (size_t)(row0 + ai * HALF + m * 16);
                *(u32x4*)(Hb + row * DE + u.pn * HALF + c8) = pack8(swiglu4(acc[ai][0][m][0], acc[ai][1][m][0]), swiglu4(acc[ai][0][m][1], acc[ai][1][m][1])); }
    } };
constexpr float H8_SCALE = 32.0f;
struct FEpiGU8 { static constexpr bool PERM = true; unsigned char* Hb; const float* RW;
    __device__ __forceinline__ void operator()(AccRef acc, const Unit& u, int wr, int wc, int fr, int fq) const {
        const int row0 = u.pm * BM + wr * 64 + fr, c8 = wc * 32 + 8 * fq;
        float rw[2][4];
#pragma unroll
        for (int ai = 0; ai < 2; ++ai)
#pragma unroll
            for (int m = 0; m < 4; ++m) rw[ai][m] = RW[row0 + ai * HALF + m * 16];
#pragma unroll
        for (int ai = 0; ai < 2; ++ai)
#pragma unroll
            for (int mp = 0; mp < 2; ++mp) { const float w0 = rw[ai][2 * mp] * H8_SCALE, w1 = rw[ai][2 * mp + 1] * H8_SCALE;
                const size_t row = (size_t)(row0 + ai * HALF + mp * 32 + (fq & 1) * 16);
                *(u32x4*)(Hb + row * DE + u.pn * HALF + wc * 32 + 16 * (fq >> 1)) = widen16(
                    (u32x2){pk4_fp8_(swiglu4(acc[ai][0][2 * mp][0], acc[ai][1][2 * mp][0]) * w0), pk4_fp8_(swiglu4(acc[ai][0][2 * mp][1], acc[ai][1][2 * mp][1]) * w0)},
                    (u32x2){pk4_fp8_(swiglu4(acc[ai][0][2 * mp + 1][0], acc[ai][1][2 * mp + 1][0]) * w1), pk4_fp8_(swiglu4(acc[ai][0][2 * mp + 1][1], acc[ai][1][2 * mp + 1][1]) * w1)}); }
    } };
constexpr float Y8_SCALE = 16.0f;
__device__ __forceinline__ unsigned pk4_fp8(f32x4 v) { int w = 0; w = cvt2_fp8(v[0], v[1], w, false); w = cvt2_fp8(v[2], v[3], w, true); return (unsigned)w; }
struct FEpiDown { static constexpr bool PERM = true; unsigned char* Yb;
    __device__ __forceinline__ void operator()(AccRef acc, const Unit& u, int wr, int wc, int fr, int fq) const {
        const int row0 = u.pm * BM + wr * 64 + fr + (fq & 1) * 16, colb = u.pn * BM + wc * 32 + 16 * (fq >> 1);
#pragma unroll
        for (int ai = 0; ai < 2; ++ai)
#pragma unroll
            for (int mp = 0; mp < 2; ++mp) { const size_t row = (size_t)(row0 + ai * HALF + mp * 32);
#pragma unroll
                for (int bj = 0; bj < 2; ++bj) *(u32x4*)(Yb + row * D + colb + bj * HALF) =
                    widen16((u32x2){pk4_fp8(acc[ai][bj][2 * mp][0]), pk4_fp8(acc[ai][bj][2 * mp][1])}, (u32x2){pk4_fp8(acc[ai][bj][2 * mp + 1][0]), pk4_fp8(acc[ai][bj][2 * mp + 1][1])}); }
    } };
struct FEpiPlain { static constexpr bool PERM = true; bf16_t* Ob;
    __device__ __forceinline__ void operator()(AccRef acc, const Unit& u, int wr, int wc, int fr, int fq) const {
        const int row0 = u.pm * BM + wr * 64 + fr, col0 = u.pn * BM + wc * 32 + 8 * fq;
#pragma unroll
        for (int ai = 0; ai < 2; ++ai)
#pragma unroll
            for (int m = 0; m < 4; ++m) { const size_t row = (size_t)(row0 + ai * HALF + m * 16);
#pragma unroll
                for (int bj = 0; bj < 2; ++bj) *(u32x4*)(Ob + row * D + col0 + bj * HALF) = pack8(acc[ai][bj][m][0], acc[ai][bj][m][1]); }
    } };
template <bool RF32> struct FEpiResB { static constexpr bool PERM = true; bf16_t* O; const void* R;
    __device__ __forceinline__ void operator()(AccRef acc, const Unit& u, int wr, int wc, int fr, int fq) const {
        const int row0 = u.pm * BM + wr * 64 + fr, col0 = u.pn * BM + wc * 32 + 8 * fq;
        u32x4 r0[2][2][2], r1[2][2][2];
#define RES_LD(buf, k_) do { _Pragma("unroll") for (int mi = 0; mi < 2; ++mi) _Pragma("unroll") for (int bj = 0; bj < 2; ++bj) { \
            const size_t off_ = (size_t)(row0 + ((k_) >> 1) * HALF + (2 * ((k_) & 1) + mi) * 16) * D + col0 + bj * HALF; \
            if (RF32) { EPI_GLD16(r0[buf][mi][bj], (const float*)R + off_); EPI_GLD16(r1[buf][mi][bj], (const float*)R + off_ + 4); } else EPI_GLD16(r0[buf][mi][bj], (const bf16_t*)R + off_); } } while (0)
        RES_LD(0, 0);
#pragma unroll
        for (int k = 0; k < 4; ++k) {
            const int cb = k & 1;
            if (k < 3) { if (cb == 0) RES_LD(1, k + 1); else RES_LD(0, k + 1); }
            if (k < 3) { if (RF32) asm volatile("s_waitcnt vmcnt(8)" ::: "memory"); else asm volatile("s_waitcnt vmcnt(4)" ::: "memory"); } else asm volatile("s_waitcnt vmcnt(0)" ::: "memory");
#pragma unroll
            for (int mi = 0; mi < 2; ++mi)
#pragma unroll
                for (int bj = 0; bj < 2; ++bj) { asm volatile("" : "+v"(r0[cb][mi][bj])); if (RF32) asm volatile("" : "+v"(r1[cb][mi][bj]));
                    const int ai = k >> 1, m = 2 * (k & 1) + mi; const size_t off = (size_t)(row0 + ai * HALF + m * 16) * D + col0 + bj * HALF;
                    f32x4 a0, a1;
                    if (RF32) { a0 = __builtin_bit_cast(f32x4, r0[cb][mi][bj]); a1 = __builtin_bit_cast(f32x4, r1[cb][mi][bj]); } else unpack8(r0[cb][mi][bj], a0, a1);
                    *(u32x4*)(O + off) = pack8(a0 * ALPHA + acc[ai][bj][m][0], a1 * ALPHA + acc[ai][bj][m][1]); }
        }
#undef RES_LD
    } };
}

__device__ __forceinline__ void cvt_item(const float* W, int ldw, int col0, int k0, bf16* WT, int ldd, int row0, LAS float* scr, int lane) {
#pragma unroll 8
    for (int i = 0; i < 32; ++i) { const int kk = 2 * i + (lane >> 5); scr[kk * 33 + (lane & 31)] = W[(size_t)(k0 + kk) * ldw + col0 + (lane & 31)]; }
    asm volatile("s_waitcnt lgkmcnt(0)" ::: "memory");
    const int c = lane & 7;
#pragma unroll
    for (int j = 0; j < 4; ++j) { const int n = (lane >> 3) + 8 * j; const LAS float* s = scr + (8 * c) * 33 + n;
        u32x4 o; o.x = pk2(s[0 * 33], s[1 * 33]); o.y = pk2(s[2 * 33], s[3 * 33]); o.z = pk2(s[4 * 33], s[5 * 33]); o.w = pk2(s[6 * 33], s[7 * 33]);
        *(u32x4*)(WT + (size_t)(row0 + n) * ldd + k0 + 8 * c) = o; }
    asm volatile("s_waitcnt lgkmcnt(0)" ::: "memory");
}

__device__ __forceinline__ void cvt_load(float (&r)[32], const float* src, int ldw, int lane) {
#pragma unroll
    for (int i = 0; i < 32; ++i) r[i] = src[(size_t)(2 * i + (lane >> 5)) * ldw + (lane & 31)];
}
__device__ __forceinline__ void cvt_store(const float (&r)[32], bf16* dst, int ldd, LAS float* scr, int lane) {
#pragma unroll
    for (int i = 0; i < 32; ++i) scr[(2 * i + (lane >> 5)) * 33 + (lane & 31)] = r[i];
    asm volatile("s_waitcnt lgkmcnt(0)" ::: "memory");
    const int c = lane & 7;
#pragma unroll
    for (int j = 0; j < 4; ++j) { const int n = (lane >> 3) + 8 * j; const LAS float* s = scr + (8 * c) * 33 + n;
        u32x4 o; o.x = pk2(s[0 * 33], s[1 * 33]); o.y = pk2(s[2 * 33], s[3 * 33]); o.z = pk2(s[4 * 33], s[5 * 33]); o.w = pk2(s[6 * 33], s[7 * 33]);
        *(u32x4*)(dst + (size_t)n * ldd + 8 * c) = o; }
    asm volatile("s_waitcnt lgkmcnt(0)" ::: "memory");
}

__device__ __forceinline__ void cvt_load4(f32x4 (&r)[8], const float* src, int ldw, int lane) {
#pragma unroll
    for (int i = 0; i < 8; ++i) r[i] = *(const f32x4*)(src + (size_t)(8 * i + (lane >> 3)) * ldw + 4 * (lane & 7));
}
__device__ __forceinline__ void cvt_store4(const f32x4 (&r)[8], bf16* dst, int ldd, LAS float* scr, int lane) {
#pragma unroll
    for (int i = 0; i < 8; ++i) { LAS float* d = scr + (8 * i + (lane >> 3)) * 33 + 4 * (lane & 7); d[0] = r[i][0]; d[1] = r[i][1]; d[2] = r[i][2]; d[3] = r[i][3]; }
    asm volatile("s_waitcnt lgkmcnt(0)" ::: "memory");
    const int c = lane & 7;
#pragma unroll
    for (int j = 0; j < 4; ++j) { const int n = (lane >> 3) + 8 * j; const LAS float* s = scr + (8 * c) * 33 + n;
        u32x4 o; o.x = pk2(s[0 * 33], s[1 * 33]); o.y = pk2(s[2 * 33], s[3 * 33]); o.z = pk2(s[4 * 33], s[5 * 33]); o.w = pk2(s[6 * 33], s[7 * 33]);
        *(u32x4*)(dst + (size_t)n * ldd + 8 * c) = o; }
    asm volatile("s_waitcnt lgkmcnt(0)" ::: "memory");
}

constexpr float W8_SCALE = 64.0f;
__device__ __forceinline__ void cvt_store4_f8(const f32x4 (&r)[8], unsigned char* dst, int ldd, LAS float* scr, int lane) {
#pragma unroll
    for (int i = 0; i < 8; ++i) { LAS float* d = scr + (8 * i + (lane >> 3)) * 33 + 4 * (lane & 7); d[0] = r[i][0]; d[1] = r[i][1]; d[2] = r[i][2]; d[3] = r[i][3]; }
    asm volatile("s_waitcnt lgkmcnt(0)" ::: "memory");
    const int c = lane & 7;
#pragma unroll
    for (int j = 0; j < 4; ++j) { const int n = (lane >> 3) + 8 * j; const LAS float* s = scr + (8 * c) * 33 + n;
        int w0 = 0, w1 = 0;
        w0 = cvt2_fp8(s[0 * 33] * W8_SCALE, s[1 * 33] * W8_SCALE, w0, false); w0 = cvt2_fp8(s[2 * 33] * W8_SCALE, s[3 * 33] * W8_SCALE, w0, true);
        w1 = cvt2_fp8(s[4 * 33] * W8_SCALE, s[5 * 33] * W8_SCALE, w1, false); w1 = cvt2_fp8(s[6 * 33] * W8_SCALE, s[7 * 33] * W8_SCALE, w1, true);
        *(u32x2*)(dst + (size_t)n * ldd + 8 * c) = (u32x2){(unsigned)w0, (unsigned)w1}; }
    asm volatile("s_waitcnt lgkmcnt(0)" ::: "memory");
}

__device__ __forceinline__ void cvt_item_f8(const float* W, int ldw, int col0, int k0, unsigned char* WT, int ldd, int row0, LAS float* scr, int lane) {
#pragma unroll 8
    for (int i = 0; i < 32; ++i) { const int kk = 2 * i + (lane >> 5); scr[kk * 33 + (lane & 31)] = W[(size_t)(k0 + kk) * ldw + col0 + (lane & 31)]; }
    asm volatile("s_waitcnt lgkmcnt(0)" ::: "memory");
    const int c = lane & 7;
#pragma unroll
    for (int j = 0; j < 4; ++j) { const int n = (lane >> 3) + 8 * j; const LAS float* s = scr + (8 * c) * 33 + n;
        int w0 = 0, w1 = 0;
        w0 = cvt2_fp8(s[0 * 33] * W8_SCALE, s[1 * 33] * W8_SCALE, w0, false); w0 = cvt2_fp8(s[2 * 33] * W8_SCALE, s[3 * 33] * W8_SCALE, w0, true);
        w1 = cvt2_fp8(s[4 * 33] * W8_SCALE, s[5 * 33] * W8_SCALE, w1, false); w1 = cvt2_fp8(s[6 * 33] * W8_SCALE, s[7 * 33] * W8_SCALE, w1, true);
        *(u32x2*)(WT + (size_t)(row0 + n) * ldd + k0 + 8 * c) = (u32x2){(unsigned)w0, (unsigned)w1}; }
    asm volatile("s_waitcnt lgkmcnt(0)" ::: "memory");
}
namespace attn_body {
typedef unsigned short bf16;
using bf16x8=__attribute__((ext_vector_type(8)))short;
using s16x4=__attribute__((ext_vector_type(4)))short;
using f32x16=__attribute__((ext_vector_type(16)))float;
using u32x4=__attribute__((ext_vector_type(4)))unsigned;
constexpr int BATCH=4,NHEAD=8,SEQ=8192,D=64,DM=4352,OP=512;
constexpr int NW=8,QBLK=32,QB=QBLK*NW,KVBLK=64,NQB=SEQ/QB;
constexpr int ATTN_UNIT_ROWS=QB;
__device__ __forceinline__ int crow(int r,int hi){return (r&3)+8*(r>>2)+4*hi;}
#define SBAR() __builtin_amdgcn_sched_barrier(0)
__device__ __forceinline__ void cmask(f32x16&p0,f32x16&p1,int jb,int qrel,int hi){
  const float NEG=-INFINITY; int kb=64*jb+4*hi;
  #pragma unroll
  for(int r=0;r<16;++r){int kv=kb+(r&3)+8*(r>>2); if(kv>qrel)p0[r]=NEG; if(kv+32>qrel)p1[r]=NEG;}
}

constexpr int NSLOT=3, SLOTB=8192;
constexpr int LDS_K=0, LDS_V=NSLOT*SLOTB, LDS_WS=2*NSLOT*SLOTB, LDS_OST=LDS_WS+NW*64*4, LDS_KB=LDS_OST+NW*4096, LDS_BYTES=LDS_KB+4*256;
constexpr float O8_SCALE=16.0f;
constexpr int SKIP_LDS=LDS_BYTES;
constexpr float C2=0.125f*1.4426950408889634f;
__device__ __forceinline__ void glds16(const void*gsrc,unsigned lds_dst){unsigned keep;
  asm volatile("s_mov_b32 %0, m0\n\ts_mov_b32 m0, %2\n\ts_nop 0\n\tglobal_load_lds_dwordx4 %1, off\n\ts_mov_b32 m0, %0":"=&s"(keep):"v"(gsrc),"s"(lds_dst):"memory");}
__device__ __forceinline__ void glds4(const void*gsrc,unsigned lds_dst){unsigned keep;
  asm volatile("s_mov_b32 %0, m0\n\ts_mov_b32 m0, %2\n\ts_nop 0\n\tglobal_load_lds_dword %1, off\n\ts_mov_b32 m0, %0":"=&s"(keep):"v"(gsrc),"s"(lds_dst):"memory");}
__device__ __forceinline__ float max3f(float a,float b,float c){float r;asm("v_max3_f32 %0, %1, %2, %3":"=v"(r):"v"(a),"v"(b),"v"(c));return r;}
__device__ __forceinline__ float max2f(float a,float b){float r;asm("v_max_f32_e32 %0, %1, %2":"=v"(r):"v"(a),"v"(b));return r;}
__device__ __forceinline__ float fadd_s(float a,float b){float r;asm("v_add_f32_e32 %0, %1, %2":"=v"(r):"v"(a),"v"(b));return r;}
__device__ __forceinline__ float fsub_s(float a,float b){float r;asm("v_sub_f32_e32 %0, %1, %2":"=v"(r):"v"(a),"v"(b));return r;}
typedef float f32x2_t __attribute__((ext_vector_type(2))); typedef __bf16 bf16x2_t __attribute__((ext_vector_type(2)));
__device__ __forceinline__ unsigned cvtpk_s(float lo,float hi){f32x2_t v={lo,hi};bf16x2_t b=__builtin_convertvector(v,bf16x2_t);return __builtin_bit_cast(unsigned,b);}
#define WAIT_BAR(N) asm volatile("s_waitcnt vmcnt(" #N ") lgkmcnt(0)\n\ts_barrier":::"memory")

__device__ __forceinline__ void qkt(f32x16&p0,f32x16&p1,const char*Kslot,const bf16x8*qr,int r32,int hi){
  const char*kb=Kslot+hi*1024+r32*16;
  #pragma unroll
  for(int d0=0;d0<4;++d0){
    const bf16x8 b0=*reinterpret_cast<const bf16x8*>(kb+d0*2048);
    const bf16x8 b1=*reinterpret_cast<const bf16x8*>(kb+d0*2048+512);
    p0=__builtin_amdgcn_mfma_f32_32x32x16_bf16(b0,qr[d0],p0,0,0,0);p1=__builtin_amdgcn_mfma_f32_32x32x16_bf16(b1,qr[d0],p1,0,0,0);}
}
typedef __attribute__((address_space(3))) const char* lds_cptr;
typedef short v4i16_t __attribute__((ext_vector_type(4)));
__device__ __forceinline__ void kload8(bf16x8*kf,lds_cptr kp){
  kf[0]=*(const __attribute__((address_space(3))) bf16x8*)(kp);      kf[1]=*(const __attribute__((address_space(3))) bf16x8*)(kp+512);
  kf[2]=*(const __attribute__((address_space(3))) bf16x8*)(kp+2048); kf[3]=*(const __attribute__((address_space(3))) bf16x8*)(kp+2560);
  kf[4]=*(const __attribute__((address_space(3))) bf16x8*)(kp+4096); kf[5]=*(const __attribute__((address_space(3))) bf16x8*)(kp+4608);
  kf[6]=*(const __attribute__((address_space(3))) bf16x8*)(kp+6144); kf[7]=*(const __attribute__((address_space(3))) bf16x8*)(kp+6656);
}
__device__ __forceinline__ void kload2(bf16x8*kf,lds_cptr kp,int j){ kf[2*j]=*(const __attribute__((address_space(3))) bf16x8*)(kp+j*2048); kf[2*j+1]=*(const __attribute__((address_space(3))) bf16x8*)(kp+j*2048+512); }
__device__ __forceinline__ s16x4 vtr(lds_cptr p){ return __builtin_bit_cast(s16x4,__builtin_amdgcn_ds_read_tr16_b64_v4i16((__attribute__((address_space(3))) v4i16_t*)p)); }
__device__ __forceinline__ float rowmax(const f32x16&p0,const f32x16&p1){
  float a=max3f(p0[0],p0[1],p1[0]),b=max3f(p0[2],p0[3],p1[1]);a=max3f(a,p1[2],p1[3]);
  #pragma unroll
  for(int r=4;r<16;r+=4){a=max3f(a,p0[r],p0[r+1]);b=max3f(b,p0[r+2],p0[r+3]);a=max3f(a,p1[r],p1[r+1]);b=max3f(b,p1[r+2],p1[r+3]);}
  const float m=max2f(a,b);
  auto rr=__builtin_amdgcn_permlane32_swap(__float_as_uint(m),__float_as_uint(m),false,false);
  return max2f(__uint_as_float(rr[0]),__uint_as_float(rr[1]));
}
__device__ __forceinline__ void pv(f32x16*o,int vb,bf16x8 pa0,bf16x8 pa1,bf16x8 pa2,bf16x8 pa3){
  #pragma unroll
  for(int d0=0;d0<2;++d0){s16x4 lo[4],hi[4];
    #pragma unroll
    for(int ks=0;ks<4;++ks){
      asm volatile("ds_read_b64_tr_b16 %0,%1 offset:%c2":"=&v"(lo[ks]):"v"(vb),"i"(d0*4096+ks*1024):"memory");
      asm volatile("ds_read_b64_tr_b16 %0,%1 offset:%c2":"=&v"(hi[ks]):"v"(vb),"i"(d0*4096+ks*1024+512):"memory");}
    asm volatile("s_waitcnt lgkmcnt(0)":::"memory");SBAR();
    #define PK(k) (bf16x8){lo[k][0],lo[k][1],lo[k][2],lo[k][3],hi[k][0],hi[k][1],hi[k][2],hi[k][3]}
    o[d0]=__builtin_amdgcn_mfma_f32_32x32x16_bf16(pa0,PK(0),o[d0],0,0,0);
    o[d0]=__builtin_amdgcn_mfma_f32_32x32x16_bf16(pa1,PK(1),o[d0],0,0,0);
    o[d0]=__builtin_amdgcn_mfma_f32_32x32x16_bf16(pa2,PK(2),o[d0],0,0,0);
    o[d0]=__builtin_amdgcn_mfma_f32_32x32x16_bf16(pa3,PK(3),o[d0],0,0,0);
    #undef PK
  }
}

#ifndef ATTN_STORE16
#define ATTN_STORE16(p,v) (*(u32x4*)(p)=(v))
#endif
template<int THRL> __device__ __forceinline__ void attn_unit(int tid,int b,int h,int qb,const bf16*Q,const bf16*__restrict__ K,const bf16*__restrict__ V,const float*__restrict__ KB,const float*__restrict__ KN2,bf16*O,char*shm){
  const int lane=tid&63,r32=lane&31,hi=lane>>5; const int wid=__builtin_amdgcn_readfirstlane(tid>>6);
  const long rowbase=(long)b*SEQ; const int q0=qb*QB;
  const bf16*Qw=Q+(rowbase+q0+wid*QBLK)*DM+h*D;
  bf16x8 qr[4];
  #pragma unroll
  for(int d0=0;d0<4;++d0)qr[d0]=*reinterpret_cast<const bf16x8*>(&Qw[(long)r32*DM+d0*16+hi*8]);
  int T0=0;
  { const int NTf=(q0+QB)/KVBLK;
    if(NTf>4){
      __attribute__((address_space(3))) float* wmx=(__attribute__((address_space(3))) float*)((const __attribute__((address_space(3))) char*)shm+SKIP_LDS);
      __attribute__((address_space(3))) int* tst=(__attribute__((address_space(3))) int*)(wmx+8);
      float ss=0.f;
      #pragma unroll
      for(int d0=0;d0<4;++d0)
        #pragma unroll
        for(int e=0;e<8;++e){const float x=__uint_as_float(((unsigned)(unsigned short)qr[d0][e])<<16); ss+=x*x;}
      {auto rr=__builtin_amdgcn_permlane32_swap(__float_as_uint(ss),__float_as_uint(ss),false,false);ss=__uint_as_float(rr[0])+__uint_as_float(rr[1]);}
      const float wm=wave_max_all(ss);
      if(lane==0)wmx[wid]=wm; if(tid==0)*tst=NTf-4;
      asm volatile("s_waitcnt lgkmcnt(0)\n\ts_barrier":::"memory");
      float q2=wmx[0];
      #pragma unroll
      for(int w=1;w<8;++w)q2=__builtin_fmaxf(q2,wmx[w]);
      const int tile=tid>>2, quarter=tid&3;
      if(tile<NTf-4){
        const float*kn=KN2+((rowbase+(long)tile*64+quarter*16)*8+h); float m2=0.f;
        #pragma unroll
        for(int i=0;i<16;++i)m2=__builtin_fmaxf(m2,kn[i*8]);
        m2=__builtin_fmaxf(m2,dpp_f<0xB1>(m2)); m2=__builtin_fmaxf(m2,dpp_f<0x4E>(m2));
        const float*kbh=KB+(long)(b*NHEAD+h)*SEQ;
        const float bound=sqrtf(q2*m2)*1.01f+kbh[tile*64+63]-kbh[q0];
        if(quarter==0&&!(bound<-152.f))__hip_atomic_fetch_min(tst,tile,__ATOMIC_RELAXED,__HIP_MEMORY_SCOPE_WORKGROUP);
      }
      asm volatile("s_waitcnt vmcnt(0) lgkmcnt(0)\n\ts_barrier":::"memory");
      T0=__builtin_amdgcn_readfirstlane(*tst)&~1;
    } }
  const bf16*Kh=K+(rowbase+(long)T0*KVBLK)*DM+h*D,*Vh=V+(rowbase+(long)T0*KVBLK)*DM+h*D;
  const unsigned lds0=(unsigned)(uintptr_t)shm; const __attribute__((address_space(3))) char* shm3_=(const __attribute__((address_space(3))) char*)shm;
  float*wsf=(float*)(shm+LDS_WS)+wid*64;
  const bf16*ksrc=Kh+(long)lane*DM+wid*8;
  const bf16*vsrc=Vh+(long)(16*(wid&3)+(lane>>2))*DM+(wid>>2)*32+(lane&3)*8;
  const unsigned kdst=lds0+LDS_K+wid*1024, vdst=lds0+LDS_V+wid*1024;
  const float*bsrc=KB+(long)(b*NHEAD+h)*SEQ+T0*KVBLK+lane; const unsigned bdst=lds0+LDS_KB;
  #define DMA_K(t,slot) do{ glds4(bsrc+(long)(t)*KVBLK,(unsigned)__builtin_amdgcn_readfirstlane(bdst+(((t)&3)<<8))); glds16(ksrc+(long)(t)*KVBLK*DM,(unsigned)__builtin_amdgcn_readfirstlane(kdst+(slot))); }while(0)
  #define DMA_V(t,slot) glds16(vsrc+(long)(t)*KVBLK*DM,(unsigned)__builtin_amdgcn_readfirstlane(vdst+(slot)))
  const int vb0=(int)(lds0+LDS_V)+((lane>>4)&1)*32+(lane&3)*8+(4*hi+((lane&15)>>2))*64;
  const char*Kbase=shm+LDS_K; bf16x8 kf[8];
  const lds_cptr shm3=(lds_cptr)shm; const lds_cptr kp0=shm3+LDS_K+hi*1024+r32*16; const lds_cptr vp0=shm3+LDS_V+((lane>>4)&1)*32+(lane&3)*8+(4*hi+((lane&15)>>2))*64;
  const int NT=(q0+QB)/KVBLK-T0;
  DMA_K(0,0);DMA_V(0,0);DMA_K(1,SLOTB);
  float mhat=KB[(long)(b*NHEAD+h)*SEQ+q0+wid*QBLK+r32],l_reg=0.f;f32x16 o[2];o[0]=f32x16{};o[1]=f32x16{};
  typedef __attribute__((address_space(3))) const float* lds_fptr; typedef float f32x4_t __attribute__((ext_vector_type(4)));
  const lds_fptr kbp=(lds_fptr)(shm3_+LDS_KB+hi*16);
  #define CINIT(C0,C1,t) do{ const lds_fptr bs_=kbp+(((t)&3)<<6); const float nm_=-mhat; \
    _Pragma("unroll") for(int g_=0;g_<4;++g_){ const f32x4_t x0_=*(const __attribute__((address_space(3))) f32x4_t*)(bs_+8*g_), x1_=*(const __attribute__((address_space(3))) f32x4_t*)(bs_+32+8*g_); \
      C0[4*g_]=x0_[0]+nm_;C0[4*g_+1]=x0_[1]+nm_;C0[4*g_+2]=x0_[2]+nm_;C0[4*g_+3]=x0_[3]+nm_; C1[4*g_]=x1_[0]+nm_;C1[4*g_+1]=x1_[1]+nm_;C1[4*g_+2]=x1_[2]+nm_;C1[4*g_+3]=x1_[3]+nm_; } }while(0)
  const int qrel=wid*QBLK+r32;
  #define CMASK(P0,P1,t) do{int jb_=(t)-(NT-4); if(jb_>=0)cmask(P0,P1,jb_,qrel,hi);}while(0)
  bool resc=false;
  #define START(P0,P1) do{ const float rm=rowmax(P0,P1); resc=false; \
    { const float dl=max2f(rm,0.f); mhat=fadd_s(mhat,dl); \
      _Pragma("unroll") for(int r=0;r<16;++r){P0[r]=fsub_s(P0[r],dl);P1[r]=fsub_s(P1[r],dl);} } \
    _Pragma("unroll") for(int r=0;r<16;++r)P0[r]=__builtin_amdgcn_exp2f(P0[r]); }while(0)
  #define RESC() do{ if(resc){ asm volatile("s_waitcnt lgkmcnt(0)":::"memory"); \
      _Pragma("unroll") for(int d_=0;d_<2;++d_) _Pragma("unroll") for(int r=0;r<16;++r)o[d_][r]*=wsf[crow(r,hi)]; } }while(0)
  f32x16 pA0,pA1,pB0,pB1;
  int sl_prev=0,sl_cur=0,sl_next=SLOTB;
  #define ROT() do{sl_prev=sl_cur;sl_cur=sl_next;sl_next=(sl_next==(NSLOT-1)*SLOTB)?0:sl_next+SLOTB;}while(0)
  DMA_K(2,2*SLOTB);
  WAIT_BAR(5);
  CINIT(pA0,pA1,0);
  qkt(pA0,pA1,Kbase,qr,r32,hi);asm volatile("s_nop 15\n\ts_nop 7":"+v"(pA0),"+v"(pA1));CMASK(pA0,pA1,0);
  START(pA0,pA1);
  _Pragma("unroll") for(int r=0;r<16;++r)pA1[r]=__builtin_amdgcn_exp2f(pA1[r]);
  WAIT_BAR(0);
  DMA_K(3,0);DMA_V(1,SLOTB);
  ROT();
  kload8(kf,kp0+sl_cur);
  WAIT_BAR(3);
  s16x4 vlo[8],vhi[8]; u32x4 pw0,pw1,pw2,pw3;
  #define PKW(P,B) cvtpk_s(P[B],P[B+1])
  #define PAF(k) __builtin_bit_cast(bf16x8,pw##k)
  #define VFR(i) (bf16x8){vlo[i][0],vlo[i][1],vlo[i][2],vlo[i][3],vhi[i][0],vhi[i][1],vhi[i][2],vhi[i][3]}
  #define PIN(x) asm volatile("":"+v"(x))
  #define MX3(a,b,c) __builtin_fmaxf(__builtin_fmaxf((a),(b)),(c))
  #define GAPA(MF,A0,A1,A2,A3,W0,W1,PW) do{ MF; sacc+=A0; sacc+=A1; sacc+=A2; sacc+=A3; PIN(sacc); W0; W1; PIN(PW); SBAR(); }while(0)
  #define EX(v) __builtin_amdgcn_exp2f(v)
  #define GAPB(MF,X,B) do{ MF; X[B]=EX(X[B]); X[B+1]=EX(X[B+1]); X[B+2]=EX(X[B+2]); X[B+3]=EX(X[B+3]); PIN(X); SBAR(); }while(0)
  #define VRD(i) do{ vlo[i]=vtr(vp_+(((i)>>2)*4096+((i)&3)*1024)); vhi[i]=vtr(vp_+(((i)>>2)*4096+((i)&3)*1024+512)); }while(0)
  #define KRD(G,j) do{ if(G){ kload2(kf,kp0+sl_next,j); SBAR(); } }while(0)
  #define STEP(C0,C1,P0,P1,t,GK,GV,GL) do{ SBAR(); \
    const lds_cptr vp_=vp0+sl_prev; \
    CINIT(C0,C1,t); SBAR(); \
    VRD(0); SBAR(); float sacc=(P0[0]+P0[1]); \
    GAPA(C0=__builtin_amdgcn_mfma_f32_32x32x16_bf16(kf[0],qr[0],C0,0,0,0), P0[2],P0[3],P0[4],P0[5],     pw0[0]=PKW(P0,0), pw0[1]=PKW(P0,2), pw0); \
    VRD(4); SBAR(); GAPA(C1=__builtin_amdgcn_mfma_f32_32x32x16_bf16(kf[1],qr[0],C1,0,0,0), P0[6],P0[7],P0[8],P0[9],     pw0[2]=PKW(P0,4), pw0[3]=PKW(P0,6), pw0); \
    VRD(1); SBAR(); GAPA(C0=__builtin_amdgcn_mfma_f32_32x32x16_bf16(kf[2],qr[1],C0,0,0,0),   P0[10],P0[11],P0[12],P0[13], pw1[0]=PKW(P0,8), pw1[1]=PKW(P0,10), pw1); \
    VRD(5); SBAR(); GAPA(C1=__builtin_amdgcn_mfma_f32_32x32x16_bf16(kf[3],qr[1],C1,0,0,0),   P0[14],P0[15],P1[0],P1[1],   pw1[2]=PKW(P0,12),pw1[3]=PKW(P0,14), pw1); \
    VRD(2); SBAR(); GAPA(C0=__builtin_amdgcn_mfma_f32_32x32x16_bf16(kf[4],qr[2],C0,0,0,0),   P1[2],P1[3],P1[4],P1[5],     pw2[0]=PKW(P1,0), pw2[1]=PKW(P1,2), pw2); \
    VRD(6); SBAR(); GAPA(C1=__builtin_amdgcn_mfma_f32_32x32x16_bf16(kf[5],qr[2],C1,0,0,0),   P1[6],P1[7],P1[8],P1[9],     pw2[2]=PKW(P1,4), pw2[3]=PKW(P1,6), pw2); \
    VRD(3); SBAR(); GAPA(C0=__builtin_amdgcn_mfma_f32_32x32x16_bf16(kf[6],qr[3],C0,0,0,0),   P1[10],P1[11],P1[12],P1[13], pw3[0]=PKW(P1,8), pw3[1]=PKW(P1,10), pw3); \
    VRD(7); SBAR(); GAPA(C1=__builtin_amdgcn_mfma_f32_32x32x16_bf16(kf[7],qr[3],C1,0,0,0),   P1[14],P1[15],0.f,0.f,       pw3[2]=PKW(P1,12),pw3[3]=PKW(P1,14), pw3); \
    l_reg+=sacc; \
    if(GK){DMA_K((t)+3,sl_cur);} if(GV){DMA_V((t)+1,sl_next);} \
    CMASK(C0,C1,t); \
    { float a=MX3(C0[0],C0[1],C1[0]),b=MX3(C0[2],C0[3],C1[1]); a=MX3(a,C1[2],C1[3]); \
      _Pragma("unroll") for(int r=4;r<16;r+=4){a=MX3(a,C0[r],C0[r+1]);b=MX3(b,C0[r+2],C0[r+3]);a=MX3(a,C1[r],C1[r+1]);b=MX3(b,C1[r+2],C1[r+3]);} \
      float rm=__builtin_fmaxf(a,b); { auto rr=__builtin_amdgcn_permlane32_swap(__float_as_uint(rm),__float_as_uint(rm),false,false); rm=__builtin_fmaxf(__uint_as_float(rr[0]),__uint_as_float(rr[1])); } \
      resc=false; \
      if(__builtin_expect(__any(rm>(float)THRL),0)){ const float dl=__builtin_fmaxf(rm,0.f); mhat+=dl; \
        _Pragma("unroll") for(int r=0;r<16;++r){C0[r]-=dl;C1[r]-=dl;} \
        const float f=__builtin_amdgcn_exp2f(-dl); l_reg*=f; if(hi==0)wsf[r32]=f; resc=true; } } \
    SBAR(); \
    GAPB(o[0]=__builtin_amdgcn_mfma_f32_32x32x16_bf16(PAF(0),VFR(0),o[0],0,0,0), C0,0); \
    GAPB(o[1]=__builtin_amdgcn_mfma_f32_32x32x16_bf16(PAF(0),VFR(4),o[1],0,0,0), C0,4); \
    KRD(GL,0); GAPB(o[0]=__builtin_amdgcn_mfma_f32_32x32x16_bf16(PAF(1),VFR(1),o[0],0,0,0), C0,8); \
    KRD(GL,1); GAPB(o[1]=__builtin_amdgcn_mfma_f32_32x32x16_bf16(PAF(1),VFR(5),o[1],0,0,0), C0,12); \
    KRD(GL,2); GAPB(o[0]=__builtin_amdgcn_mfma_f32_32x32x16_bf16(PAF(2),VFR(2),o[0],0,0,0), C1,0); \
    KRD(GL,3); GAPB(o[1]=__builtin_amdgcn_mfma_f32_32x32x16_bf16(PAF(2),VFR(6),o[1],0,0,0), C1,4); \
    GAPB(o[0]=__builtin_amdgcn_mfma_f32_32x32x16_bf16(PAF(3),VFR(3),o[0],0,0,0), C1,8); \
    GAPB(o[1]=__builtin_amdgcn_mfma_f32_32x32x16_bf16(PAF(3),VFR(7),o[1],0,0,0), C1,12); \
    }while(0)
  int t=1;
  #undef CMASK
  #define CMASK(P0,P1,t) do{}while(0)
  for(;t+5<NT;t+=2){
    STEP(pB0,pB1,pA0,pA1,t,true,true,true);     WAIT_BAR(3); RESC(); ROT();
    STEP(pA0,pA1,pB0,pB1,t+1,true,true,true);   WAIT_BAR(3); RESC(); ROT();
  }
  #undef CMASK
  #define CMASK(P0,P1,t) do{int jb_=(t)-(NT-4); if(jb_>=0)cmask(P0,P1,jb_,qrel,hi);}while(0)
  #define ENDW(tt) do{ if((tt)+3<NT){WAIT_BAR(3);} else if((tt)+2<NT){WAIT_BAR(1);} else {WAIT_BAR(0);} }while(0)
  for(;t+1<NT;t+=2){
    STEP(pB0,pB1,pA0,pA1,t,(t+3<NT),(t+1<NT),(t+1<NT));       ENDW(t);   RESC(); ROT();
    STEP(pA0,pA1,pB0,pB1,t+1,(t+4<NT),(t+2<NT),(t+2<NT));     ENDW(t+1); RESC(); ROT();
  }
  STEP(pB0,pB1,pA0,pA1,NT-1,false,false,false); RESC();
  { float sacc=pB0[0]+pB0[1]; _Pragma("unroll") for(int r=2;r<16;++r)sacc+=pB0[r]; _Pragma("unroll") for(int r=0;r<16;++r)sacc+=pB1[r]; l_reg+=sacc;
    pw0=(u32x4){PKW(pB0,0),PKW(pB0,2),PKW(pB0,4),PKW(pB0,6)};pw1=(u32x4){PKW(pB0,8),PKW(pB0,10),PKW(pB0,12),PKW(pB0,14)};pw2=(u32x4){PKW(pB1,0),PKW(pB1,2),PKW(pB1,4),PKW(pB1,6)};pw3=(u32x4){PKW(pB1,8),PKW(pB1,10),PKW(pB1,12),PKW(pB1,14)};
    SBAR(); pv(o,vb0+sl_cur,PAF(0),PAF(1),PAF(2),PAF(3)); }
  #undef PKW
  #undef PAF
  #undef VFR
  #undef PIN
  #undef MX3
  #undef GAPA
  #undef GAPB
  #undef EX
  #undef VRD
  #undef KRD
  #undef STEP
  #undef ENDW
  {auto rr=__builtin_amdgcn_permlane32_swap(__float_as_uint(l_reg),__float_as_uint(l_reg),false,false);l_reg=__uint_as_float(rr[0])+__uint_as_float(rr[1]);}
  if(hi==0)wsf[32+r32]=l_reg;asm volatile("s_waitcnt lgkmcnt(0)":::"memory");
  float rli[16];
  #pragma unroll
  for(int r=0;r<16;++r)rli[r]=__builtin_amdgcn_rcpf(wsf[32+crow(r,hi)]);
  unsigned char*Ow=(unsigned char*)O+(rowbase+q0+wid*QBLK)*OP+h*D;
  { unsigned char*stg=(unsigned char*)(shm+LDS_OST)+wid*2048;
    #pragma unroll
    for(int r=0;r<16;++r){const int orow=crow(r,hi); const float sc_=rli[r]*O8_SCALE;
      const int w_=cvt2_fp8(o[0][r]*sc_,o[1][r]*sc_,0,false);
      stg[orow*64+r32]=(unsigned char)w_; stg[orow*64+32+r32]=(unsigned char)(w_>>8);}
    asm volatile("s_waitcnt lgkmcnt(0)":::"memory");
    #pragma unroll
    for(int i=0;i<2;++i){const int row=i*16+(lane>>2),ch=lane&3; const u32x4 v=*(const u32x4*)(stg+row*64+ch*16); ATTN_STORE16(Ow+(long)row*OP+ch*16,v);} }
  asm volatile("s_waitcnt lgkmcnt(0)\n\ts_barrier":::"memory");
  #undef DMA_K
  #undef CINIT
  #undef DMA_V
  #undef CMASK
  #undef START
  #undef RESC
  #undef ROT
}

constexpr int SWA_TAB=SKIP_LDS+64;
constexpr int SWA_LDS_BYTES=SWA_TAB+2*4*256*4;
__device__ __forceinline__ void swa_tables(int tid,const float*relb,const unsigned char*bucket,char*shm){
  __attribute__((address_space(3))) float* tab=(__attribute__((address_space(3))) float*)((const __attribute__((address_space(3))) char*)shm+SWA_TAB);
  #pragma unroll
  for(int k=0;k<4;++k){ const int idx=tid+512*k, hq=idx>>8, e=(idx&255)-64; tab[idx]=(e>=0&&e<128)?relb[(int)bucket[e]*8+hq]*1.4426950408889634f:-INFINITY; }
}
__device__ __forceinline__ void swa_unit(int tid,int b,int kvh,int qt,const bf16*Q,const bf16*__restrict__ K,const bf16*__restrict__ V,const float*sinks,bf16*O,char*shm){
  const int lane=tid&63,r32=lane&31,hi=lane>>5; const int wid=__builtin_amdgcn_readfirstlane(tid>>6);
  const int h4=wid>>1, hq=kvh*4+h4, qhalf=wid&1;
  const long rowbase=(long)b*SEQ; const int q0=qt*64;
  const bf16*Qw=Q+(rowbase+q0+qhalf*32)*DM+hq*D;
  const bf16*Kh=K+rowbase*DM+kvh*D,*Vh=V+rowbase*DM+kvh*D;
  const unsigned lds0=(unsigned)(uintptr_t)shm; const __attribute__((address_space(3))) char* shm3_=(const __attribute__((address_space(3))) char*)shm;
  float*wsf=(float*)(shm+LDS_WS)+wid*64;
  const int kt_lo=qt>=2?qt-2:0, ntile=qt-kt_lo+1;
  const bf16*ksrc=Kh+(long)lane*DM+wid*8;
  const bf16*vsrc=Vh+(long)(16*(wid&3)+(lane>>2))*DM+(wid>>2)*32+(lane&3)*8;
  const unsigned kdst=lds0+LDS_K+wid*1024, vdst=lds0+LDS_V+wid*1024;
  #pragma unroll
  for(int j=0;j<3;++j) if(j<ntile){ glds16(ksrc+(long)(kt_lo+j)*KVBLK*DM,(unsigned)__builtin_amdgcn_readfirstlane(kdst+j*SLOTB)); glds16(vsrc+(long)(kt_lo+j)*KVBLK*DM,(unsigned)__builtin_amdgcn_readfirstlane(vdst+j*SLOTB)); }
  bf16x8 qr[4];
  #pragma unroll
  for(int d0=0;d0<4;++d0)qr[d0]=*reinterpret_cast<const bf16x8*>(&Qw[(long)r32*DM+d0*16+hi*8]);
  const float sink2=sinks[hq]*1.4426950408889634f;
  WAIT_BAR(0);
  const char*Kbase=shm+LDS_K;
  const __attribute__((address_space(3))) float* tabh=(const __attribute__((address_space(3))) float*)(shm3_+SWA_TAB)+(kvh*4+h4)*256+64;
  const int tq=q0+qhalf*32+r32;
  const float NEG=-INFINITY;
  f32x16 p[3][2];
  float mx=NEG;
  #pragma unroll
  for(int j=0;j<3;++j){
    if(j<ntile){
      p[j][0]=f32x16{};p[j][1]=f32x16{};
      qkt(p[j][0],p[j][1],Kbase+j*SLOTB,qr,r32,hi);
      const int kb=(kt_lo+j)*64+4*hi;
      #pragma unroll
      for(int r=0;r<16;++r){ const int kv=kb+(r&3)+8*(r>>2); const int d0_=tq-kv;
        p[j][0][r]+=tabh[d0_]; p[j][1][r]+=tabh[d0_-32];
        mx=__builtin_fmaxf(mx,__builtin_fmaxf(p[j][0][r],p[j][1][r])); }
    } else {
      #pragma unroll
      for(int r=0;r<16;++r){p[j][0][r]=NEG;p[j][1][r]=NEG;} }
  }
  { auto rr=__builtin_amdgcn_permlane32_swap(__float_as_uint(mx),__float_as_uint(mx),false,false); mx=__builtin_fmaxf(__uint_as_float(rr[0]),__uint_as_float(rr[1])); }
  mx=__builtin_fmaxf(mx,sink2);
  float l_reg=0.f;
  #pragma unroll
  for(int j=0;j<3;++j)
    #pragma unroll
    for(int r=0;r<16;++r){ p[j][0][r]=__builtin_amdgcn_exp2f(p[j][0][r]-mx); p[j][1][r]=__builtin_amdgcn_exp2f(p[j][1][r]-mx); l_reg+=p[j][0][r]+p[j][1][r]; }
  f32x16 o[2];o[0]=f32x16{};o[1]=f32x16{};
  const int vb0=(int)(lds0+LDS_V)+((lane>>4)&1)*32+(lane&3)*8+(4*hi+((lane&15)>>2))*64;
  #define PKW(P,B) cvtpk_s(P[B],P[B+1])
  #pragma unroll
  for(int j=0;j<3;++j) if(j<ntile){
    u32x4 pw0=(u32x4){PKW(p[j][0],0),PKW(p[j][0],2),PKW(p[j][0],4),PKW(p[j][0],6)},pw1=(u32x4){PKW(p[j][0],8),PKW(p[j][0],10),PKW(p[j][0],12),PKW(p[j][0],14)};
    u32x4 pw2=(u32x4){PKW(p[j][1],0),PKW(p[j][1],2),PKW(p[j][1],4),PKW(p[j][1],6)},pw3=(u32x4){PKW(p[j][1],8),PKW(p[j][1],10),PKW(p[j][1],12),PKW(p[j][1],14)};
    SBAR(); pv(o,vb0+j*SLOTB,__builtin_bit_cast(bf16x8,pw0),__builtin_bit_cast(bf16x8,pw1),__builtin_bit_cast(bf16x8,pw2),__builtin_bit_cast(bf16x8,pw3)); }
  #undef PKW
  {auto rr=__builtin_amdgcn_permlane32_swap(__float_as_uint(l_reg),__float_as_uint(l_reg),false,false);l_reg=__uint_as_float(rr[0])+__uint_as_float(rr[1]);}
  l_reg+=__builtin_amdgcn_exp2f(sink2-mx);
  if(hi==0)wsf[32+r32]=l_reg;asm volatile("s_waitcnt lgkmcnt(0)":::"memory");
  float rli[16];
  #pragma unroll
  for(int r=0;r<16;++r)rli[r]=__builtin_amdgcn_rcpf(wsf[32+crow(r,hi)]);
  unsigned char*Ow=(unsigned char*)O+(rowbase+q0+qhalf*32)*OP+hq*D;
  { unsigned char*stg=(unsigned char*)(shm+LDS_OST)+wid*2048;
    #pragma unroll
    for(int r=0;r<16;++r){const int orow=crow(r,hi); const float sc_=rli[r]*O8_SCALE;
      const int w_=cvt2_fp8(o[0][r]*sc_,o[1][r]*sc_,0,false);
      stg[orow*64+r32]=(unsigned char)w_; stg[orow*64+32+r32]=(unsigned char)(w_>>8);}
    asm volatile("s_waitcnt lgkmcnt(0)":::"memory");
    #pragma unroll
    for(int i=0;i<2;++i){const int row=i*16+(lane>>2),ch=lane&3; const u32x4 v=*(const u32x4*)(stg+row*64+ch*16); ATTN_STORE16(Ow+(long)row*OP+ch*16,v);} }
  asm volatile("s_waitcnt lgkmcnt(0)\n\ts_barrier":::"memory");
}
constexpr int ATTN_LDS_BYTES=SWA_LDS_BYTES;
struct AttnTensors { const unsigned char* base; long oQ, oK, oV, oKB, oKN2, oO; };
struct AttnUnit { int bh; int qb; };
struct StaticOrder {
  int vcu;
  __device__ __forceinline__ explicit StaticOrder(int grid,int block):vcu((block%8)*(grid/8)+block/8){}
  __device__ __forceinline__ bool next(int i,AttnUnit&u)const{ if(i>=4)return false; const int s=vcu&7; u.bh=vcu>>3; u.qb=(i==0)?s:(i==1)?15-s:(i==2)?16+s:31-s; return true; }
  __device__ __forceinline__ void a_ready(const AttnUnit&)const{}
  __device__ __forceinline__ void done(const AttnUnit&)const{}
};
struct SnakeOrder {
  int na, v;
  __device__ __forceinline__ SnakeOrder(int na_,int v_):na(na_),v(v_){}
  __device__ __forceinline__ bool next(int i,AttnUnit&u)const{ const int j=i*na+((i&1)?na-1-v:v); if(j>=32*NQB)return false; u.bh=j&31; u.qb=NQB-1-(j>>5); return true; }
  __device__ __forceinline__ void a_ready(const AttnUnit&)const{}
  __device__ __forceinline__ void done(const AttnUnit&)const{}
};
struct QueueOrder {
  unsigned* head; __attribute__((address_space(3))) int* slot; int tid;
  __device__ __forceinline__ bool next(int i,AttnUnit&u)const{
    if(tid==0)slot[i&1]=(int)__hip_atomic_fetch_add(head,1u,__ATOMIC_RELAXED,__HIP_MEMORY_SCOPE_AGENT);
    asm volatile("s_waitcnt vmcnt(0) lgkmcnt(0)\n\ts_barrier":::"memory");
    const int j=__builtin_amdgcn_readfirstlane(slot[i&1]); if(j>=32*NQB)return false; u.bh=j&31; u.qb=NQB-1-(j>>5); return true; }
  __device__ __forceinline__ void a_ready(const AttnUnit&)const{}
  __device__ __forceinline__ void done(const AttnUnit&)const{}
};
template<class Sched,int THRL=8> __device__ __forceinline__ void attn_phase(int tid,char*lds,const AttnTensors&T,const Sched&S){
  AttnUnit u;
  for(int i=0;S.next(i,u);++i){ const unsigned char* wb=T.base; asm volatile("":"+s"(wb)); const __attribute__((address_space(1))) unsigned char* gb=(const __attribute__((address_space(1))) unsigned char*)wb;
    int tid2=tid; asm volatile("":"+v"(tid2));
    attn_unit<THRL>(tid2,u.bh/NHEAD,u.bh%NHEAD,u.qb,(const bf16*)(gb+T.oQ),(const bf16*)(gb+T.oK),(const bf16*)(gb+T.oV),(const float*)(gb+T.oKB),(const float*)(gb+T.oKN2),(bf16*)(gb+T.oO),lds); }
}
#undef SBAR
#undef WAIT_BAR
}

struct Args { const float* in[20]; float* out; unsigned char* ws; int ph_lo, ph_hi; };
enum { I_X = 0, I_WIN, I_BF, I_SINK, I_RELB, I_WPA, I_WPB, I_WOUT, I_LN1G, I_LN1B, I_WR, I_RB, I_WGE, I_WUE, I_WDE, I_WGS, I_WUS, I_WDS, I_LN2G, I_LN2B };
enum { PH_CVT = 0, PH_INPROJ, PH_ATTN, PH_PROJ, PH_OUT, PH_LN1, PH_RS, PH_ROUTE, PH_OFFS, PH_GU, PH_DOWN, PH_LN2, NPH };
static_assert(NCHUNK == NE, "PH_OFFS: block c owns chunk c and expert c");

struct NGemm {
    const bf16* A; int lda; const int* ridx;
    const float* B; const float* B2; int ldb;
    int K; int bskip_at, bskip;
};
template <bool DUAL, class Epi>
__device__ __forceinline__ void ngemm_tile(const NGemm& g, int row0, int col0, LAS float* lds, const Epi& epi) {
    const int tid = threadIdx.x;
    LAS float* As = lds; LAS float* Bs = lds + 16 * 132; LAS float* Bs2 = Bs + 16 * 128;
    const int ty = tid >> 5, tx = tid & 31;
    float acc[8][4], acc2[8][4];
#pragma unroll
    for (int i = 0; i < 8; ++i)
#pragma unroll
        for (int j = 0; j < 4; ++j) { acc[i][j] = 0.f; acc2[i][j] = 0.f; }
    const int ar = tid >> 2, akq = (tid & 3) * 4;
    const int arow = g.ridx ? g.ridx[row0 + ar] : row0 + ar;
    const bf16* ap = g.A + (size_t)arow * g.lda + akq;
    const int bk = tid >> 5, bn = (tid & 31) * 4;
    int scol = col0 + bn; scol += (scol >= g.bskip_at) ? g.bskip : 0;
    const float* bp = g.B + (size_t)bk * g.ldb + scol;
    const float* bp2 = DUAL ? g.B2 + (size_t)bk * g.ldb + scol : nullptr;
    for (int k0 = 0; k0 < g.K; k0 += 16) {
        const u32x2 av = *(const u32x2*)(ap + k0);
        const f32x4 bv = *(const f32x4*)(bp + (size_t)k0 * g.ldb);
        f32x4 bv2 = (f32x4){0.f, 0.f, 0.f, 0.f};
        if (DUAL) bv2 = *(const f32x4*)(bp2 + (size_t)k0 * g.ldb);
        __syncthreads();
        As[(akq + 0) * 132 + ar] = bf2f(av.x & 0xffffu); As[(akq + 1) * 132 + ar] = bf2f(av.x >> 16);
        As[(akq + 2) * 132 + ar] = bf2f(av.y & 0xffffu); As[(akq + 3) * 132 + ar] = bf2f(av.y >> 16);
        *(LAS f32x4*)(Bs + bk * 128 + bn) = bv;
        if (DUAL) *(LAS f32x4*)(Bs2 + bk * 128 + bn) = bv2;
        __syncthreads();
#pragma unroll 2
        for (int kk = 0; kk < 16; ++kk) {
            const f32x4 a0 = *(const LAS f32x4*)(As + kk * 132 + ty * 8), a1 = *(const LAS f32x4*)(As + kk * 132 + ty * 8 + 4);
            const f32x4 b = *(const LAS f32x4*)(Bs + kk * 128 + tx * 4);
            const float a[8] = {a0.x, a0.y, a0.z, a0.w, a1.x, a1.y, a1.z, a1.w};
#pragma unroll
            for (int i = 0; i < 8; ++i) { acc[i][0] += a[i] * b.x; acc[i][1] += a[i] * b.y; acc[i][2] += a[i] * b.z; acc[i][3] += a[i] * b.w; }
            if (DUAL) {
                const f32x4 b2 = *(const LAS f32x4*)(Bs2 + kk * 128 + tx * 4);
#pragma unroll
                for (int i = 0; i < 8; ++i) { acc2[i][0] += a[i] * b2.x; acc2[i][1] += a[i] * b2.y; acc2[i][2] += a[i] * b2.z; acc2[i][3] += a[i] * b2.w; }
            }
        }
    }
#pragma unroll
    for (int i = 0; i < 8; ++i)
        epi(row0 + ty * 8 + i, col0 + tx * 4, (f32x4){acc[i][0], acc[i][1], acc[i][2], acc[i][3]}, (f32x4){acc2[i][0], acc2[i][1], acc2[i][2], acc2[i][3]});
    __syncthreads();
}

struct EpiInProj { bf16* P;
    __device__ __forceinline__ void operator()(int row, int col, f32x4 a, f32x4) const {
        if (col < PC_AK || (col >= PC_BQ && col < PC_BK)) a = a * C2;
        else if (col >= PC_GA) { a.x = sigmoidf_(a.x); a.y = sigmoidf_(a.y); a.z = sigmoidf_(a.z); a.w = sigmoidf_(a.w); }
        *(u32x2*)(P + (size_t)row * PC + col) = (u32x2){pk2(a.x, a.y), pk2(a.z, a.w)}; } };
struct EpiMix { bf16* MIXB; const bf16* P; int gcol; bool add;
    __device__ __forceinline__ void operator()(int row, int col, f32x4 a, f32x4) const {
        const u32x2 gv = *(const u32x2*)(P + (size_t)row * PC + gcol + col);
        f32x4 r = (f32x4){bf2f(gv.x & 0xffffu) * a.x, bf2f(gv.x >> 16) * a.y, bf2f(gv.y & 0xffffu) * a.z, bf2f(gv.y >> 16) * a.w};
        bf16* mp = MIXB + (size_t)row * D + col;
        if (add) { const u32x2 mv = *(const u32x2*)mp; r.x += bf2f(mv.x & 0xffffu); r.y += bf2f(mv.x >> 16); r.z += bf2f(mv.y & 0xffffu); r.w += bf2f(mv.y >> 16); }
        *(u32x2*)mp = (u32x2){pk2(r.x, r.y), pk2(r.z, r.w)}; } };
struct EpiRes { float* O; const float* R;
    __device__ __forceinline__ void operator()(int row, int col, f32x4 a, f32x4) const {
        const f32x4 r = *(const f32x4*)(R + (size_t)row * D + col);
        *(f32x4*)(O + (size_t)row * D + col) = r * ALPHA + a; } };
struct EpiF32 { float* O; int ldo;
    __device__ __forceinline__ void operator()(int row, int col, f32x4 a, f32x4) const { *(f32x4*)(O + (size_t)row * ldo + col) = a; } };
struct EpiSwiglu { bf16* O; int ldo;
    __device__ __forceinline__ void operator()(int row, int col, f32x4 g, f32x4 u) const {
        *(u32x2*)(O + (size_t)row * ldo + col) = (u32x2){pk2(siluf_(g.x) * u.x, siluf_(g.y) * u.y), pk2(siluf_(g.z) * u.z, siluf_(g.w) * u.w)}; } };
struct EpiDown { bf16* Y; const float* RW;
    __device__ __forceinline__ void operator()(int row, int col, f32x4 a, f32x4) const {
        const float w = RW[row]; *(u32x2*)(Y + (size_t)row * D + col) = (u32x2){pk2(a.x * w, a.y * w), pk2(a.z * w, a.w * w)}; } };

template <bool SWA>
__device__ __forceinline__ void nattn_unit(int tid, int b, int h, int qt, const bf16* Pj, const float* Cc, const float* relb, float sinkv, bf16* O, LAS float* lds) {
    const int qi = tid >> 3, sub = tid & 7;
    const int t = qt * 64 + qi;
    const size_t row = (size_t)b * SEQ + t;
    const int qcol = SWA ? PC_AQ + h * 64 : PC_BQ + h * 64;
    const int kcol = SWA ? PC_AK + (h >> 2) * 64 : PC_BK + h * 64;
    const int vcol = SWA ? PC_AV + (h >> 2) * 64 : PC_BV + h * 64;
    float q[8], o[8];
    { const u32x4 v = *(const u32x4*)(Pj + row * PC + qcol + sub * 8);
      q[0] = bf2f(v.x & 0xffffu); q[1] = bf2f(v.x >> 16); q[2] = bf2f(v.y & 0xffffu); q[3] = bf2f(v.y >> 16);
      q[4] = bf2f(v.z & 0xffffu); q[5] = bf2f(v.z >> 16); q[6] = bf2f(v.w & 0xffffu); q[7] = bf2f(v.w >> 16); }
    const float cq = SWA ? 0.f : Cc[row * 8 + h];
    LAS float* Ks = lds; LAS float* Vs = lds + 64 * 68; LAS float* Cs = Vs + 64 * 68;
    float m = -1e30f, l = 0.f;
#pragma unroll
    for (int d = 0; d < 8; ++d) o[d] = 0.f;
    const int kt_lo = SWA ? (qt >= 2 ? qt - 2 : 0) : 0;
    for (int kt = kt_lo; kt <= qt; ++kt) {
        __syncthreads();
        { const int key = tid >> 3, d8 = (tid & 7) * 8; const size_t krow = (size_t)b * SEQ + kt * 64 + key;
          const u32x4 kv = *(const u32x4*)(Pj + krow * PC + kcol + d8), vv = *(const u32x4*)(Pj + krow * PC + vcol + d8);
          LAS float* kd = Ks + key * 68 + d8; LAS float* vd = Vs + key * 68 + d8;
          *(LAS f32x4*)kd = (f32x4){bf2f(kv.x & 0xffffu), bf2f(kv.x >> 16), bf2f(kv.y & 0xffffu), bf2f(kv.y >> 16)};
          *(LAS f32x4*)(kd + 4) = (f32x4){bf2f(kv.z & 0xffffu), bf2f(kv.z >> 16), bf2f(kv.w & 0xffffu), bf2f(kv.w >> 16)};
          *(LAS f32x4*)vd = (f32x4){bf2f(vv.x & 0xffffu), bf2f(vv.x >> 16), bf2f(vv.y & 0xffffu), bf2f(vv.y >> 16)};
          *(LAS f32x4*)(vd + 4) = (f32x4){bf2f(vv.z & 0xffffu), bf2f(vv.z >> 16), bf2f(vv.w & 0xffffu), bf2f(vv.w >> 16)};
          if (!SWA && (tid & 7) == 0) Cs[key] = Cc[krow * 8 + h]; }
        __syncthreads();
#pragma unroll 2
        for (int j = 0; j < 64; ++j) {
            const int s = kt * 64 + j;
            const f32x4 k0 = *(const LAS f32x4*)(Ks + j * 68 + sub * 8), k1 = *(const LAS f32x4*)(Ks + j * 68 + sub * 8 + 4);
            float dot = q[0] * k0.x + q[1] * k0.y + q[2] * k0.z + q[3] * k0.w + q[4] * k1.x + q[5] * k1.y + q[6] * k1.z + q[7] * k1.w;
            dot += __shfl_xor(dot, 1); dot += __shfl_xor(dot, 2); dot += __shfl_xor(dot, 4);
            const int dist = t - s;
            const bool valid = (dist >= 0) && (!SWA || dist < WIN);
            float bias;
            if (SWA) { const int dc = dist < 0 ? 0 : (dist > 127 ? 127 : dist); bias = relb[(int)T5_BUCKET[dc] * 8 + h] * LOG2E; }
            else bias = (cq - Cs[j]) * LOG2E;
            const float sc = valid ? dot + bias : -1e30f;
            const float mnew = fmaxf(m, sc), al = exp2f(m - mnew), p = valid ? exp2f(sc - mnew) : 0.f;
            l = l * al + p; m = mnew;
            const f32x4 v0 = *(const LAS f32x4*)(Vs + j * 68 + sub * 8), v1 = *(const LAS f32x4*)(Vs + j * 68 + sub * 8 + 4);
            o[0] = o[0] * al + p * v0.x; o[1] = o[1] * al + p * v0.y; o[2] = o[2] * al + p * v0.z; o[3] = o[3] * al + p * v0.w;
            o[4] = o[4] * al + p * v1.x; o[5] = o[5] * al + p * v1.y; o[6] = o[6] * al + p * v1.z; o[7] = o[7] * al + p * v1.w;
        }
    }
    float r = 1.f, denom = l;
    if (SWA) { const float sk = sinkv * LOG2E, Mf = fmaxf(m, sk); r = exp2f(m - Mf); denom = l * r + exp2f(sk - Mf); }
    const float inv = r / denom;
    *(u32x4*)(O + row * 512 + h * 64 + sub * 8) = (u32x4){pk2(o[0] * inv, o[1] * inv), pk2(o[2] * inv, o[3] * inv), pk2(o[4] * inv, o[5] * inv), pk2(o[6] * inv, o[7] * inv)};
}

__device__ __forceinline__ void route_token(int t, const float* LG, f32x4 rb, int* TE, float* TW, LAS int* hist, int lane) {
    const f32x4 lg = *(const f32x4*)(LG + (size_t)t * NE + lane * 4);
    float sc[4] = {sigmoidf_(lg.x), sigmoidf_(lg.y), sigmoidf_(lg.z), sigmoidf_(lg.w)};
    float bi[4] = {sc[0] + rb.x, sc[1] + rb.y, sc[2] + rb.z, sc[3] + rb.w};
    float a1 = fmaxf(bi[0], bi[1]), a2 = fminf(bi[0], bi[1]);
#pragma unroll
    for (int i = 2; i < 4; ++i) { const float v = bi[i]; const float n1 = fmaxf(a1, v), n2 = fmaxf(a2, fminf(a1, v)); a1 = n1; a2 = n2; }
    { float b1 = dpp_f<0xB1>(a1), b2 = dpp_f<0xB1>(a2); float n1 = fmaxf(a1, b1), n2 = fmaxf(fminf(a1, b1), fmaxf(a2, b2)); a1 = n1; a2 = n2;
      b1 = dpp_f<0x4E>(a1); b2 = dpp_f<0x4E>(a2); n1 = fmaxf(a1, b1); n2 = fmaxf(fminf(a1, b1), fmaxf(a2, b2)); a1 = n1; a2 = n2;
      b1 = dpp_f<0x141>(a1); b2 = dpp_f<0x141>(a2); n1 = fmaxf(a1, b1); n2 = fmaxf(fminf(a1, b1), fmaxf(a2, b2)); a1 = n1; a2 = n2; }
    const float gs = a1 + a2; const int mygrp = lane >> 3; int rank = 0;
#pragma unroll
    for (int g = 0; g < NG; ++g) { const float v = rdlane_f(gs, g * 8); rank += (v > gs || (v == gs && g < mygrp)) ? 1 : 0; }
    const bool sel = rank < TOPG;
    const float NEG = -__builtin_inff();
    float cv[4];
#pragma unroll
    for (int i = 0; i < 4; ++i) cv[i] = sel ? bi[i] : NEG;
    int my_e = 0; float my_w = 0.f, tot = 0.f;
#pragma unroll
    for (int r = 0; r < TOPK; ++r) {
        const float vmax = wave_max_all(fmaxf(fmaxf(cv[0], cv[1]), fmaxf(cv[2], cv[3])));
        int id = 1 << 20;
#pragma unroll
        for (int i = 0; i < 4; ++i) { const unsigned long long bl = __ballot(cv[i] == vmax); const int c = bl ? (int)__builtin_ctzll(bl) * 4 + i : (1 << 20); id = c < id ? c : id; }
        const int el = id & 3, ow = id >> 2;
        const float ssel = el == 0 ? sc[0] : (el == 1 ? sc[1] : (el == 2 ? sc[2] : sc[3]));
        const float wsc = rdlane_f(ssel, ow);
        tot += wsc;
        if (lane == r) { my_e = id; my_w = wsc; }
#pragma unroll
        for (int i = 0; i < 4; ++i) if (lane == ow && i == el) cv[i] = NEG;
    }
    if (lane < TOPK) { TE[(size_t)t * TOPK + lane] = my_e; TW[(size_t)t * TOPK + lane] = my_w / tot * ROUTED_SCALE; __hip_atomic_fetch_add(hist + my_e, 1, __ATOMIC_RELAXED, __HIP_MEMORY_SCOPE_WORKGROUP); }
}

__device__ __forceinline__ void ln_row(f32x4 (&v)[4], const float* g, const float* bta, int lane) {
    float s = 0.f;
#pragma unroll
    for (int j = 0; j < 4; ++j) s += (v[j].x + v[j].y) + (v[j].z + v[j].w);
    const float mean = wave_sum(s) * (1.f / D); float s2 = 0.f;
#pragma unroll
    for (int j = 0; j < 4; ++j) { v[j] = v[j] - mean; s2 += (v[j].x * v[j].x + v[j].y * v[j].y) + (v[j].z * v[j].z + v[j].w * v[j].w); }
    const float rstd = 1.f / sqrtf(wave_sum(s2) * (1.f / D) + LN_EPS);
#pragma unroll
    for (int j = 0; j < 4; ++j) { const f32x4 gg = *(const f32x4*)(g + lane * 4 + 256 * j), bb = *(const f32x4*)(bta + lane * 4 + 256 * j); v[j] = v[j] * rstd * gg + bb; }
}

#ifndef REP_CVT
#define REP_CVT 1
#endif
#ifndef REP_INPROJ
#define REP_INPROJ 1
#endif
#ifndef REP_ATTN
#define REP_ATTN 1
#endif
#ifndef REP_PROJA
#define REP_PROJA 1
#endif
#ifndef REP_OUT
#define REP_OUT 1
#endif
#ifndef REP_LN1
#define REP_LN1 1
#endif
#ifndef REP_RS
#define REP_RS 1
#endif
#ifndef REP_ROUTE
#define REP_ROUTE 1
#endif
#ifndef REP_OFFS
#define REP_OFFS 1
#endif
#ifndef REP_GU
#define REP_GU 1
#endif
#ifndef REP_DOWN
#define REP_DOWN 1
#endif
#ifndef REP_LN2
#define REP_LN2 1
#endif
#ifndef REP_SWA
#define REP_SWA 1
#endif
#ifndef REP_CONV
#define REP_CONV 1
#endif
#ifndef REP_ATTN
#define REP_ATTN 1
#endif
#define IN(k) (lo <= (k) && (k) < hi)
#define SEAM(k) do { if (IN(k) && IN((k) + 1)) xcd_barrier(bar); } while (0)
#define PHASE_WS unsigned char* wsp_ = args.ws; asm volatile("" : "+s"(wsp_)); GAS unsigned char* WSP = (GAS unsigned char*)wsp_; int tid = (wave0 << 6) | lane_id_opaque(); \
        const int lane = tid & 63, wave = __builtin_amdgcn_readfirstlane(tid >> 6), gw = bid * NWAVES + wave; (void)lane; (void)gw
#define LOGF ((float*)(WSP + WS_LOGF))
#define CC ((float*)(WSP + WS_C))
#define CKB ((float*)(WSP + WS_CKB))
#define KN2 ((float*)(WSP + WS_KN2))
#define TOPE ((int*)(WSP + WS_TOPE))
#define TOPW ((float*)(WSP + WS_TOPW))
#define INV ((int*)(WSP + WS_INV))
#define ROWTOK ((int*)(WSP + WS_ROWTOK))
#define ROWW ((float*)(WSP + WS_ROWW))
#define CNT ((int*)(WSP + WS_CNT))
#define BLKE ((int*)(WSP + WS_BLKE))
#define XH ((bf16*)(WSP + WS_XH))
#define X1H ((bf16*)(WSP + WS_X1H))
#define LOGITS ((float*)(WSP + WS_LOGITS))
#define HS8 ((unsigned char*)(WSP + WS_HS))
#define XA ((float*)(WSP + WS_XA))
#define PREB ((bf16*)(WSP + WS_PRE))
#define X1 ((float*)(WSP + WS_X1))
#define H8 ((unsigned char*)(WSP + WS_H))
#define XH8 ((unsigned char*)(WSP + WS_X1))
#define X1F8 ((unsigned char*)(WSP + WS_XA))
#define PROJ ((bf16*)(WSP + WS_PROJ))
#define YA ((bf16*)(WSP + WS_YA))
#define YB ((bf16*)(WSP + WS_YB))
#define MIXB ((bf16*)(WSP + WS_MIX))
#define MIX8 ((unsigned char*)(WSP + WS_MIX + 64 * MiB))
#define YY ((unsigned char*)(WSP + WS_Y))
#define YS ((bf16*)(WSP + WS_PRE))
#define WGU8 ((unsigned char*)(WSP + WS_WEXP))
#define WD8 ((unsigned char*)(WSP + WS_WEXP + 128 * MiB))
#define CTLW ((unsigned*)(WSP + WS_CTL))
#define WSM(off) ((bf16*)(WSP + WS_WSMALL + (size_t)layer * WSMALL_LAYER + (off)))
#define WIN8 ((unsigned char*)WSM(WSM_WIN))
#define WPA_T WSM(WSM_WPA)
#define WPB_T WSM(WSM_WPB)
#define WOUT_T WSM(WSM_WOUT)
#define WRS_T WSM(WSM_WRS)
#define WDS_T WSM(WSM_WDS)
#define XIN (layer == 0 ? args.in[I_X] : (const float*)XA)
#define XOUT (layer == DEPTH - 1 ? args.out : XA)
#define W_IN (args.in[I_WIN] + (size_t)layer * D * IN_COLS)

template <int layer>
__device__ __forceinline__ void layer_body(const Args& args, LAS unsigned char* lds, const XcdBarrier& bar, int G, int bid, int NGW, int wave0) {
    const int lo = args.ph_lo, hi = args.ph_hi;
    LAS int* blke_lds = (LAS int*)(lds + BLKE_LDS_OFF);
    {
        const int pb = layer * NPH;


        if (layer == 0 && IN(pb + PH_CVT)) for (int rep_ = 0; rep_ < REP_CVT; ++rep_) { PHASE_WS;
            LAS float* wz = (LAS float*)lds;
            for (int i = tid; i < D * 2; i += NTHR) { const int k = i >> 1, hh = (i & 1) * 4; *(LAS f32x4*)(wz + k * 8 + hh) = *(const f32x4*)(W_IN + (size_t)k * IN_COLS + OC_ZF + hh); }
            __syncthreads();
            {
                LAS float* scr = (LAS float*)(lds + 32768 + wave * 8448);
                int base = 0;
                const int nsmall = layer == 0 ? 12 * DEPTH : 0;
#pragma unroll 1
                for (int jj = 0; jj < nsmall; ++jj) {
                    const float* W; int ldw, K, col0, ncols, row0; bf16* WT;
                    {
                        const int l2 = jj / 12, j = jj % 12;
                        unsigned char* w2 = (unsigned char*)(WSP + WS_WSMALL + (size_t)l2 * WSMALL_LAYER);
                        const float* wg = args.in[I_WGS] + (size_t)l2 * D * DS; const float* wu = args.in[I_WUS] + (size_t)l2 * D * DS;
                        W = args.in[I_WIN] + (size_t)l2 * D * IN_COLS; ldw = IN_COLS; K = D; col0 = 0; ncols = OC_ZF; WT = (bf16*)(w2 + WSM_WIN); row0 = 0;
                        if (j == 1) { col0 = OC_GA; ncols = 2048; row0 = PC_GA; }
                        else if (j == 2) { W = args.in[I_WPA] + (size_t)l2 * 512 * D; ldw = D; K = 512; ncols = D; WT = (bf16*)(w2 + WSM_WPA); }
                        else if (j == 3) { W = args.in[I_WPB] + (size_t)l2 * 512 * D; ldw = D; K = 512; ncols = D; WT = (bf16*)(w2 + WSM_WPB); }
                        else if (j == 4) { W = args.in[I_WOUT] + (size_t)l2 * D * D; ldw = D; ncols = D; WT = (bf16*)(w2 + WSM_WOUT); }
                        else if (j >= 5 && j <= 8) { W = (j & 1) ? wg : wu; ldw = DS; col0 = j >= 7 ? 128 : 0; ncols = 128; WT = (bf16*)(w2 + WSM_WRS); row0 = (j - 5) * 128; }
                        else if (j == 9) { W = args.in[I_WR] + (size_t)l2 * D * NE; ldw = NE; ncols = NE; WT = (bf16*)(w2 + WSM_WRS); row0 = 512; }
                        else if (j == 10) { W = args.in[I_WDS] + (size_t)l2 * DS * D; ldw = D; K = DS; ncols = D; WT = (bf16*)(w2 + WSM_WDS); }
                        else if (j == 11) { ncols = 0; }
                    }
                    const bool j8 = (jj % 12) != 9;
                    const int nnb = ncols / 32, nit = (K / 64) * nnb;
                    const int first = ((gw - base) % NGW + NGW) % NGW;
                    for (int it = first; it < nit; it += NGW) { const int kb = it / nnb, nb = it % nnb; if (j8) cvt_item_f8(W, ldw, col0 + nb * 32, kb * 64, (unsigned char*)WT, K, row0 + nb * 32, scr, lane); else cvt_item(W, ldw, col0 + nb * 32, kb * 64, WT, K, row0 + nb * 32, scr, lane); }
                    base += nit;
                }
            }
            const float* bfg = args.in[I_BF] + layer * FH;
            for (int t = gw; t < T; t += NGW) {
                float z[8];
#pragma unroll
                for (int hh = 0; hh < 8; ++hh) z[hh] = 0.f;
#pragma unroll 1
                for (int j = 0; j < 4; ++j) {
                    f32x4 v;
                    if (layer == 0) { v = *(const f32x4*)(args.in[I_X] + (size_t)t * D + lane * 4 + 256 * j);
                        *(u32x2*)(XH + (size_t)t * D + lane * 4 + 256 * j) = (u32x2){pk2(v.x, v.y), pk2(v.z, v.w)};
                        *(unsigned*)(XH8 + (size_t)t * D + lane * 4 + 256 * j) = pg8::pk4_fp8_(v); }
                    else { const u32x2 xb = *(const u32x2*)(XH + (size_t)t * D + lane * 4 + 256 * j);
                        v = (f32x4){bf2f(xb.x & 0xffffu), bf2f(xb.x >> 16), bf2f(xb.y & 0xffffu), bf2f(xb.y >> 16)}; }
                    const float vv[4] = {v.x, v.y, v.z, v.w};
#pragma unroll
                    for (int e = 0; e < 4; ++e) { const int k = lane * 4 + 256 * j + e; const f32x4 w0 = *(const LAS f32x4*)(wz + k * 8), w1 = *(const LAS f32x4*)(wz + k * 8 + 4);
                        z[0] += vv[e] * w0.x; z[1] += vv[e] * w0.y; z[2] += vv[e] * w0.z; z[3] += vv[e] * w0.w; z[4] += vv[e] * w1.x; z[5] += vv[e] * w1.y; z[6] += vv[e] * w1.z; z[7] += vv[e] * w1.w; }
                }
#pragma unroll
                for (int hh = 0; hh < 8; ++hh) z[hh] = wave_sum(z[hh]);
                if (lane < 8) { float zz = z[0];
#pragma unroll
                    for (int hh = 1; hh < 8; ++hh) zz = (lane == hh) ? z[hh] : zz;
                    const float v = zz + bfg[lane];
                    LOGF[(size_t)t * 8 + lane] = fminf(v, 0.f) - log1pf(__expf(-fabsf(v))); KN2[(size_t)t * 8 + lane] = 0.f; }
            }
            __syncthreads();
        }
        if (layer == 0) SEAM(pb + PH_CVT);

        if (IN(pb + PH_INPROJ)) for (int rep_ = 0; rep_ < REP_INPROJ; ++rep_) { PHASE_WS;
            {
            LAS float* sb = (LAS float*)lds;
            for (int u = bid; u < BATCH * FH; u += G) {
                const int b = u >> 3, h = u & 7;
                float v[16], s = 0.f;
#pragma unroll
                for (int i = 0; i < 16; ++i) { v[i] = LOGF[((size_t)b * SEQ + tid * 16 + i) * 8 + h]; s += v[i]; v[i] = s; }
                __syncthreads();
                sb[tid] = s; __syncthreads();
                int cur = 0;
                for (int off = 1; off < NTHR; off <<= 1) { float x = sb[cur * 512 + tid]; if (tid >= off) x += sb[cur * 512 + tid - off]; sb[(cur ^ 1) * 512 + tid] = x; cur ^= 1; __syncthreads(); }
                const float excl = sb[cur * 512 + tid] - s;
#pragma unroll
                for (int i = 0; i < 16; ++i) { CC[((size_t)b * SEQ + tid * 16 + i) * 8 + h] = v[i] + excl; CKB[(size_t)u * SEQ + tid * 16 + i] = -(v[i] + excl) * LOG2E; }
            }
            __syncthreads();
            }
            pg8::DenseT<true> P; P.init((const bf16*)XH8, D / 2, (const bf16*)WIN8, D / 2, T, PC, D / 2, G, bid); P.sa = 0x7F7F7F7F; P.sb = 0x79797979;
            pg8::FEpiInProj E{PROJ, KN2};
            pg8::gemm_phase<pg8::FEpiInProj, pg8::DenseT<true>, true, true>(lds + RING_OFF, P, E, tid);
        }
        SEAM(pb + PH_INPROJ);

        for (int arep = 0; arep < REP_ATTN; ++arep) {
        if (IN(pb + PH_ATTN)) { PHASE_WS;
#define FOX_FROM_QUEUE() do { LAS int* qslot = (LAS int*)(lds + attn_body::SKIP_LDS + 48); \
                const attn_body::AttnTensors AT{args.ws, (long)(WS_PROJ + PC_BQ * 2), (long)(WS_PROJ + PC_BK * 2), (long)(WS_PROJ + PC_BV * 2), (long)WS_CKB, (long)WS_KN2, (long)WS_YB}; \
                const attn_body::QueueOrder S{CTLW + CW_AQ + 64 * layer + 16 * arep, qslot, tid}; \
                attn_body::attn_phase<attn_body::QueueOrder>(tid, (char*)lds, AT, S); } while (0)
            if (G == 256 && bid < NATT) FOX_FROM_QUEUE();
        }
        if (IN(pb + PH_ATTN)) { PHASE_WS;
            if (G == 256) {
                for (int rep_ = 0; rep_ < REP_CONV; ++rep_) {
                unsigned* cqh = CTLW + CW_CQ + 64 * layer + 16 * rep_ + 32 * arep;
                    LAS float* scr = (LAS float*)(lds + wave * 8448);
                const float* WGE = args.in[I_WGE] + (size_t)layer * NE * D * DE; const float* WUE = args.in[I_WUE] + (size_t)layer * NE * D * DE; const float* WDE = args.in[I_WDE] + (size_t)layer * NE * DE * D;
                constexpr int NIT_E = 3 * 32768;
#define CVT_DECODE(g_, src_, ldw_, dst_, ldd_) do { const int part_ = (g_) >> 15, r_ = (g_) & 32767, e_ = r_ >> 7, it_ = r_ & 127; \
                    if (part_ < 2) { const int kb_ = it_ >> 3, nb_ = it_ & 7; src_ = (part_ ? WUE : WGE) + (size_t)e_ * D * DE + (size_t)(kb_ * 64) * DE + nb_ * 32; ldw_ = DE; \
                        dst_ = WGU8 + (size_t)e_ * 512 * D + (size_t)((nb_ >> 2) * 256 + part_ * 128 + (nb_ & 3) * 32) * D + kb_ * 64; ldd_ = D; } \
                    else { const int kb_ = it_ >> 5, nb_ = it_ & 31; src_ = WDE + (size_t)e_ * DE * D + (size_t)(kb_ * 64) * D + nb_ * 32; ldw_ = D; \
                        dst_ = WD8 + (size_t)e_ * D * DE + (size_t)(nb_ * 32) * DE + kb_ * 64; ldd_ = DE; } } while (0)
                    constexpr int NCHK = NIT_E / 8;
                    f32x4 b0[8], b1[8], b2[8], b3[8]; const float* sp = nullptr; int lw = 0; unsigned char *d0 = nullptr, *d1 = nullptr, *d2 = nullptr, *d3 = nullptr; int l0 = 0, l1 = 0, l2 = 0, l3 = 0;
#define CVT_LD(buf, dd, ll, g_) do { CVT_DECODE((g_), sp, lw, dd, ll); cvt_load4(buf, sp, lw, lane); } while (0)
#define CVT_ST(buf, dd, ll) cvt_store4_f8(buf, dd, ll, scr, lane)
                    for (;;) {
                        int c = 0; if (lane == 0) c = (int)__hip_atomic_fetch_add(cqh, 1u, __ATOMIC_RELAXED, __HIP_MEMORY_SCOPE_AGENT);
                        c = __builtin_amdgcn_readfirstlane(c); if (c >= NCHK) break;
                        const int g = c * 8;
                        CVT_LD(b0, d0, l0, g); CVT_LD(b1, d1, l1, g + 1); CVT_LD(b2, d2, l2, g + 2);
                        CVT_LD(b3, d3, l3, g + 3); CVT_ST(b0, d0, l0);
                        CVT_LD(b0, d0, l0, g + 4); CVT_ST(b1, d1, l1);
                        CVT_LD(b1, d1, l1, g + 5); CVT_ST(b2, d2, l2);
                        CVT_LD(b2, d2, l2, g + 6); CVT_ST(b3, d3, l3);
                        CVT_LD(b3, d3, l3, g + 7); CVT_ST(b0, d0, l0);
                        CVT_ST(b1, d1, l1); CVT_ST(b2, d2, l2); CVT_ST(b3, d3, l3);
                    }
#undef CVT_LD
#undef CVT_ST
#undef CVT_DECODE
                }
                __syncthreads();
            }
        }
        if (IN(pb + PH_ATTN)) { PHASE_WS;
            if (G == 256 && bid >= NATT) FOX_FROM_QUEUE();
#undef FOX_FROM_QUEUE
        }
        if (IN(pb + PH_ATTN)) { PHASE_WS;
            const float* sinks = args.in[I_SINK] + layer * AQH; const float* relb = args.in[I_RELB];
            attn_body::swa_tables(tid, relb, T5_BUCKET, (char*)lds); __syncthreads();
            for (int rep_ = 0; rep_ < REP_SWA; ++rep_)
            for (int u = bid; u < BATCH * AKVH * (SEQ / 64); u += G) {
                const int qt = u & 127, bk = u >> 7;
                attn_body::swa_unit(tid, bk >> 1, bk & 1, qt, PROJ + PC_AQ, PROJ + PC_AK, PROJ + PC_AV, sinks, YA, (char*)lds);
            }
            __syncthreads();
        }
        }
        SEAM(pb + PH_ATTN);

        if (IN(pb + PH_PROJ)) for (int rep_ = 0; rep_ < REP_PROJA; ++rep_) { PHASE_WS;
            {   pg8::DenseT<true> P; P.init(YA, 256, WPA_T, 256, T, D, 256, G, bid); P.sa = 0x7B7B7B7B; P.sb = 0x79797979;
                pg8::FEpiMix<false> E{MIXB, MIX8, PROJ, PC_GA};
                pg8::gemm_phase<pg8::FEpiMix<false>, pg8::DenseT<true>, true, true>(lds + RING_OFF, P, E, tid); }
            {
                pg8::DenseT<true> P; P.init(YB, 256, WPB_T, 256, T, D, 256, G, bid); P.sa = 0x7B7B7B7B; P.sb = 0x79797979;
                pg8::FEpiMix<true> E{MIXB, MIX8, PROJ, PC_GB};
                pg8::gemm_phase<pg8::FEpiMix<true>, pg8::DenseT<true>, true, true>(lds + RING_OFF, P, E, tid); }
        }
        SEAM(pb + PH_PROJ);

        if (IN(pb + PH_OUT)) for (int rep_ = 0; rep_ < REP_OUT; ++rep_) { PHASE_WS;
            pg8::DenseT<true> P; P.init((const bf16*)MIX8, D / 2, WOUT_T, D / 2, T, D, D / 2, G, bid); P.sa = 0x7B7B7B7B; P.sb = 0x79797979;
            pg8::FEpiResB<layer == 0> E{PREB, layer == 0 ? (const void*)args.in[I_X] : (const void*)XH};
            pg8::gemm_phase<pg8::FEpiResB<layer == 0>, pg8::DenseT<true>, true, true>(lds + RING_OFF, P, E, tid);
        }
        SEAM(pb + PH_OUT);

        if (IN(pb + PH_LN1)) for (int rep_ = 0; rep_ < REP_LN1; ++rep_) { PHASE_WS;
            const float* gg = args.in[I_LN1G] + layer * D; const float* bb = args.in[I_LN1B] + layer * D;
            for (int t = gw; t < T; t += NGW) {
                f32x4 v[4];
#pragma unroll
                for (int j = 0; j < 4; ++j) { const u32x2 pb_ = *(const u32x2*)(PREB + (size_t)t * D + lane * 4 + 256 * j);
                    v[j] = (f32x4){bf2f(pb_.x & 0xffffu), bf2f(pb_.x >> 16), bf2f(pb_.y & 0xffffu), bf2f(pb_.y >> 16)}; }
                ln_row(v, gg, bb, lane);
#pragma unroll
                for (int j = 0; j < 4; ++j) { *(u32x2*)(X1H + (size_t)t * D + lane * 4 + 256 * j) = (u32x2){pk2(v[j].x, v[j].y), pk2(v[j].z, v[j].w)};
                    *(unsigned*)(X1F8 + (size_t)t * D + lane * 4 + 256 * j) = pg8::pk4_fp8_(v[j]); }
            }
        }
        SEAM(pb + PH_LN1);

        if (IN(pb + PH_RS)) for (int rep_ = 0; rep_ < REP_RS; ++rep_) { PHASE_WS;
            if (bid < 128) {
                pg8::Dense P; P.init(X1H, D, WRS_T + (size_t)512 * D, D, T, NE, D, 128, bid);
                pg8::FEpiRouter E{LOGITS};
                pg8::gemm_phase<pg8::FEpiRouter, pg8::Dense, true, true>(lds + RING_OFF, P, E, tid);
            } else {
                pg8::DenseT<true> P; P.init((const bf16*)X1F8, D / 2, WRS_T, D / 2, T, 512, D / 2, 128, bid - 128); P.sa = 0x7F7F7F7F; P.sb = 0x79797979;
                pg8::FEpiShared8 E{HS8};
                pg8::gemm_phase<pg8::FEpiShared8, pg8::DenseT<true>, true, true>(lds + RING_OFF, P, E, tid);
            }
        }
        SEAM(pb + PH_RS);

        if (IN(pb + PH_ROUTE)) for (int rep_ = 0; rep_ < REP_ROUTE; ++rep_) { PHASE_WS;
            LAS int* hist = (LAS int*)lds;
            const f32x4 rb = *(const f32x4*)(args.in[I_RB] + layer * NE + lane * 4);
            for (int c = bid; c < NCHUNK; c += G) {
                __syncthreads();
                if (tid < NE) hist[tid] = 0;
                __syncthreads();
                for (int i = 0; i < CHUNK / NWAVES; ++i) route_token(c * CHUNK + wave * (CHUNK / NWAVES) + i, LOGITS, rb, TOPE, TOPW, hist, lane);
                __syncthreads();
                if (tid < NE) CNT[c * NE + tid] = hist[tid];
            }
            __syncthreads();
        }
        SEAM(pb + PH_ROUTE);

        if (IN(pb + PH_OFFS)) for (int rep_ = 0; rep_ < REP_OFFS; ++rep_) { PHASE_WS;
            LAS int* sb = (LAS int*)lds;
            LAS int* base = sb + 512;
            LAS int* cursor = base + 256;
            for (int c = bid; c < NCHUNK; c += G) {
                __syncthreads();
                int tot = 0, below = 0, padded = 0;
                { const int e2 = tid & (NE - 1), half = tid >> 8;
#pragma unroll 16
                  for (int c2 = half * (NCHUNK / 2); c2 < (half + 1) * (NCHUNK / 2); ++c2) { const int v = CNT[c2 * NE + e2]; tot += v; below += (c2 < c) ? v : 0; }
                  if (half) { base[e2] = tot; cursor[e2] = below; }
                  __syncthreads();
                  if (!half) { tot += base[e2]; below += cursor[e2]; } }
                __syncthreads();
                if (tid < NE) { padded = (tot + EB - 1) / EB * EB; sb[tid] = padded; cursor[tid] = 0; }
                __syncthreads();
                int cur = 0;
                for (int off = 1; off < NE; off <<= 1) { if (tid < NE) { int x = sb[cur * 256 + tid]; if (tid >= off) x += sb[cur * 256 + tid - off]; sb[(cur ^ 1) * 256 + tid] = x; } cur ^= 1; __syncthreads(); }
                if (tid < NE) {
                    const int pend = sb[cur * 256 + tid], pstart = pend - padded;
                    base[tid] = pstart + below;
                    if (tid == c) {
                        for (int r = pstart + tot; r < pend; ++r) { ROWTOK[r] = 0; ROWW[r] = 0.f; }
                        for (int rb = pstart / EB; rb < pend / EB; ++rb) BLKE[rb] = c;
                    }
                    if (tid == NE - 1 && c == NE - 1) CTLW[CW_NB] = (unsigned)(pend / EB);
                }
                __syncthreads();
                for (int a = tid; a < CHUNK * TOPK; a += NTHR) {
                    const size_t ai = (size_t)c * CHUNK * TOPK + a; const int e = TOPE[ai];
                    const int pos = base[e] + __hip_atomic_fetch_add(cursor + e, 1, __ATOMIC_RELAXED, __HIP_MEMORY_SCOPE_WORKGROUP);
                    ROWTOK[pos] = (int)(ai >> 3); ROWW[pos] = TOPW[ai]; INV[ai] = pos;
                }
            }
            __syncthreads();
        }
        SEAM(pb + PH_OFFS);

        if (IN(pb + PH_GU)) for (int rep_ = 0; rep_ < REP_GU; ++rep_) { PHASE_WS;
            const int nb = (int)__hip_atomic_load(CTLW + CW_NB, __ATOMIC_RELAXED, __HIP_MEMORY_SCOPE_AGENT);
            for (int i = tid; i < NRB; i += NTHR) blke_lds[i] = i < nb ? BLKE[i] : 0;
            __syncthreads();
            pg8::Grouped<true, 2, true> P; P.A = (const bf16*)X1F8; P.Bt = (const bf16*)WGU8; P.K = D / 2; P.lda = D / 2; P.ldb = D / 2; P.rowidx = ROWTOK; P.blke = blke_lds; P.bstride = (size_t)512 * D / 2; P.nwg = nb * 2; P.G = G; P.c = bid;
            P.sa = 0x7F7F7F7F; P.sb = 0x79797979;
            pg8::FEpiGU8 E{H8, ROWW};
            pg8::gemm_phase<pg8::FEpiGU8, pg8::Grouped<true, 2, true>, true, true>(lds + RING_OFF, P, E, tid);
        }
        SEAM(pb + PH_GU);

        if (IN(pb + PH_DOWN)) for (int rep_ = 0; rep_ < REP_DOWN; ++rep_) { PHASE_WS;
            const int nb = (int)__hip_atomic_load(CTLW + CW_NB, __ATOMIC_RELAXED, __HIP_MEMORY_SCOPE_AGENT);
            for (int i = tid; i < NRB; i += NTHR) blke_lds[i] = i < nb ? BLKE[i] : 0;
            __syncthreads();
            { pg8::Grouped<false, 4, true> P; P.A = (const bf16*)H8; P.Bt = (const bf16*)WD8; P.K = DE / 2; P.lda = DE / 2; P.ldb = DE / 2; P.rowidx = nullptr; P.blke = blke_lds; P.bstride = (size_t)D * DE / 2; P.nwg = nb * 4; P.G = G; P.c = bid;
              P.sa = 0x7A7A7A7A; P.sb = 0x7D7D7D7D;
              pg8::FEpiDown E{YY};
              pg8::gemm_phase<pg8::FEpiDown, pg8::Grouped<false, 4, true>, true, false>(lds + RING_OFF, P, E, tid); }
        }
        if (IN(pb + PH_DOWN)) for (int rep_ = 0; rep_ < REP_DOWN; ++rep_) { PHASE_WS;
            { pg8::DenseT<true> P; P.init((const bf16*)HS8, DS / 2, WDS_T, DS / 2, T, D, DS / 2, G, bid); P.sa = 0x7C7C7C7C; P.sb = 0x79797979;
              pg8::FEpiPlain E{YS};
              pg8::gemm_phase<pg8::FEpiPlain, pg8::DenseT<true>, true, true>(lds + RING_OFF, P, E, tid); }
        }
        SEAM(pb + PH_DOWN);

        if (IN(pb + PH_LN2)) for (int rep_ = 0; rep_ < REP_LN2; ++rep_) { PHASE_WS;
            const float* gg = args.in[I_LN2G] + layer * D; const float* bb = args.in[I_LN2B] + layer * D;
            LAS float* wz = (LAS float*)lds;
            if (layer < DEPTH - 1) { const float* wn = args.in[I_WIN] + (size_t)(layer + 1) * D * IN_COLS;
                for (int i = tid; i < D * 2; i += NTHR) { const int k = i >> 1, hh = (i & 1) * 4; *(LAS f32x4*)(wz + k * 8 + hh) = *(const f32x4*)(wn + (size_t)k * IN_COLS + OC_ZF + hh); }
                __syncthreads(); }
            int ic[2], in_[2];
#pragma unroll
            for (int q = 0; q < 2; ++q) { const int tq = gw + q * NGW; ic[q] = (tq < T && lane < TOPK) ? INV[(size_t)tq * TOPK + lane] : 0; }
            for (int t = gw; t < T; t += 2 * NGW) {
                u32x2 ysr[2][4], xbr[2][4]; int y8[2][TOPK][4];
#pragma unroll
                for (int q = 0; q < 2; ++q) { const int tq = t + q * NGW; if (tq < T) {
#pragma unroll
                    for (int j = 0; j < 4; ++j) { ysr[q][j] = *(const u32x2*)(YS + (size_t)tq * D + lane * 4 + 256 * j); xbr[q][j] = *(const u32x2*)(X1H + (size_t)tq * D + lane * 4 + 256 * j); }
#pragma unroll
                    for (int k = 0; k < TOPK; ++k) { const int r = __builtin_amdgcn_readlane(ic[q], k);
#pragma unroll
                        for (int j = 0; j < 4; ++j) y8[q][k][j] = *(const int*)(YY + (size_t)r * D + lane * 4 + 256 * j); } } }
#pragma unroll
                for (int q = 0; q < 2; ++q) { const int tn = t + (2 + q) * NGW; in_[q] = (tn < T && lane < TOPK) ? INV[(size_t)tn * TOPK + lane] : 0; }
#pragma unroll
                for (int q = 0; q < 2; ++q) { const int tq = t + q * NGW; if (tq < T) {
                f32x4 v[4], racc[4];
#pragma unroll
                for (int j = 0; j < 4; ++j) { const u32x2 y = ysr[q][j], xb = xbr[q][j]; racc[j] = (f32x4){0.f, 0.f, 0.f, 0.f};
                    v[j] = (f32x4){bf2f(xb.x & 0xffffu), bf2f(xb.x >> 16), bf2f(xb.y & 0xffffu), bf2f(xb.y >> 16)} * ALPHA + (f32x4){bf2f(y.x & 0xffffu), bf2f(y.x >> 16), bf2f(y.y & 0xffffu), bf2f(y.y >> 16)}; }
#pragma unroll
                for (int k = 0; k < TOPK; ++k)
#pragma unroll
                    for (int j = 0; j < 4; ++j) { const int y = y8[q][k][j];
                        const f32x2 lo = __builtin_amdgcn_cvt_pk_f32_fp8(y, false), hi = __builtin_amdgcn_cvt_pk_f32_fp8(y, true);
                        racc[j] = racc[j] + (f32x4){lo.x, lo.y, hi.x, hi.y}; }
#pragma unroll
                for (int j = 0; j < 4; ++j) v[j] = v[j] + racc[j] * (1.0f / pg8::Y8_SCALE);
                ln_row(v, gg, bb, lane);
#pragma unroll
                for (int j = 0; j < 4; ++j) {
                    if (layer == DEPTH - 1) *(f32x4*)(args.out + (size_t)tq * D + lane * 4 + 256 * j) = v[j];
                    else { *(u32x2*)(XH + (size_t)tq * D + lane * 4 + 256 * j) = (u32x2){pk2(v[j].x, v[j].y), pk2(v[j].z, v[j].w)};
                        *(unsigned*)(XH8 + (size_t)tq * D + lane * 4 + 256 * j) = pg8::pk4_fp8_(v[j]); } }
                if (layer < DEPTH - 1) {
                    float z[8];
#pragma unroll
                    for (int hh = 0; hh < 8; ++hh) z[hh] = 0.f;
#pragma unroll 1
                    for (int j = 0; j < 4; ++j) { const float vv[4] = {v[j].x, v[j].y, v[j].z, v[j].w};
#pragma unroll
                        for (int e = 0; e < 4; ++e) { const int k = lane * 4 + 256 * j + e; const f32x4 w0 = *(const LAS f32x4*)(wz + k * 8), w1 = *(const LAS f32x4*)(wz + k * 8 + 4);
                            z[0] += vv[e] * w0.x; z[1] += vv[e] * w0.y; z[2] += vv[e] * w0.z; z[3] += vv[e] * w0.w; z[4] += vv[e] * w1.x; z[5] += vv[e] * w1.y; z[6] += vv[e] * w1.z; z[7] += vv[e] * w1.w; } }
#pragma unroll
                    for (int hh = 0; hh < 8; ++hh) z[hh] = wave_sum(z[hh]);
                    if (lane < 8) { float zz = z[0];
#pragma unroll
                        for (int hh = 1; hh < 8; ++hh) zz = (lane == hh) ? z[hh] : zz;
                        const float qv = zz + args.in[I_BF][(layer + 1) * FH + lane];
                        LOGF[(size_t)tq * 8 + lane] = fminf(qv, 0.f) - log1pf(__expf(-fabsf(qv))); KN2[(size_t)tq * 8 + lane] = 0.f; }
                }
                } }
                ic[0] = in_[0]; ic[1] = in_[1];
            }
        }
        SEAM(pb + PH_LN2);
    }
}

__global__ void __launch_bounds__(NTHR, 2) fwd_kernel(Args args) {
    extern __shared__ __attribute__((aligned(16))) unsigned char lds_raw[];
    LAS unsigned char* lds = (LAS unsigned char*)lds_raw;
    volatile LAS unsigned* MISC = (volatile LAS unsigned*)(lds + MISC_OFF);
    const int G = gridDim.x, bid = blockIdx.x, NGW = G * NWAVES;
    const int wave0 = __builtin_amdgcn_readfirstlane(threadIdx.x >> 6);
    unsigned char* ws = args.ws;
    unsigned* ctl = (unsigned*)(ws + WS_CTL);
    for (int u = threadIdx.x; u < (LDS_BYTES - LDSCTL_OFF) / 4; u += NTHR) ((LAS unsigned*)(lds + LDSCTL_OFF))[u] = 0u;
    __syncthreads();
    XcdBarrier bar = xcd_barrier_post(ctl + CW_BAR, MISC + 8, (unsigned)wave0);

    layer_body<0>(args, lds, bar, G, bid, NGW, wave0);
    layer_body<1>(args, lds, bar, G, bid, NGW, wave0);
}
#undef IN
#undef SEAM


#ifndef MK_PER_PHASE
#define MK_PER_PHASE 0
#endif
extern "C" void kernel_launch(void* const* d_in, const int* in_sizes, int n_in, void* d_out, int out_size, void* d_ws, size_t ws_size, hipStream_t stream) {
    static int grid = 0;
    if (grid == 0) {
        if (n_in != 20 || in_sizes[0] != T * D || out_size != T * D || ws_size < WS_END) { fprintf(stderr, "kernel_launch: unexpected shapes/workspace (n_in %d, ws %zu)\n", n_in, ws_size); grid = -1; return; }
        int dev = 0, cus = 0, per_cu = 0;
        if (hipGetDevice(&dev) != hipSuccess || hipDeviceGetAttribute(&cus, hipDeviceAttributeMultiprocessorCount, dev) != hipSuccess) { grid = -1; return; }
        if (hipFuncSetAttribute((const void*)fwd_kernel, hipFuncAttributeMaxDynamicSharedMemorySize, LDS_BYTES) != hipSuccess) { fprintf(stderr, "kernel_launch: hipFuncSetAttribute failed\n"); grid = -1; return; }
        if (hipOccupancyMaxActiveBlocksPerMultiprocessor(&per_cu, (const void*)fwd_kernel, NTHR, LDS_BYTES) != hipSuccess || per_cu < 1) fprintf(stderr, "kernel_launch: occupancy query reports %d\n", per_cu);
        (void)hipGetLastError();
        grid = cus;
    }
    if (grid < 0) return;
    (void)hipMemsetAsync((char*)d_ws + WS_CTL, 0, CTL_ZERO_BYTES, stream);
    Args a{};
    for (int i = 0; i < 20; ++i) a.in[i] = (const float*)d_in[i];
    a.out = (float*)d_out; a.ws = (unsigned char*)d_ws;
    constexpr int NTOT = DEPTH * NPH;
#if MK_PER_PHASE
    for (int p = 0; p < NTOT; ++p) { a.ph_lo = p; a.ph_hi = p + 1; hipLaunchKernelGGL(fwd_kernel, dim3(grid), dim3(NTHR), LDS_BYTES, stream, a); }
#else
    a.ph_lo = 0; a.ph_hi = NTOT; hipLaunchKernelGGL(fwd_kernel, dim3(grid), dim3(NTHR), LDS_BYTES, stream, a);
#endif
}
```
